# Optimizing an MI355X kernel written in HIP

```python
import jax, jax.numpy as jnp
from jax import lax
import numpy as np

D_MODEL = 1024
BATCH = 8
SEQ = 2048
DEPTH = 1

HEAD_DIM = 64
N_Q_HEADS = 8
N_KV_HEADS = 2
ATTN_WIDTH = N_Q_HEADS * HEAD_DIM
KV_WIDTH = N_KV_HEADS * HEAD_DIM
CONV_WIDTH = D_MODEL - ATTN_WIDTH
MIX_WIDTH = ATTN_WIDTH + CONV_WIDTH
CONV_KERNEL = 31
WINDOW = 128
BLOCK = 128
ROPE_THETA = 10000.0
EPS = 1e-6
IN_WIDTH = ATTN_WIDTH + 2 * KV_WIDTH + ATTN_WIDTH + 2 * CONV_WIDTH + CONV_WIDTH

kernel_name = "hybrid_swa_sink_conformer_adaln"


def _rms_norm(t, w):
    tf = t.astype(jnp.float32)
    y = tf * lax.rsqrt(jnp.mean(tf * tf, axis=-1, keepdims=True) + EPS)
    return (y * w.astype(jnp.float32)).astype(t.dtype)


def _layer_norm(t, w, b):
    tf = t.astype(jnp.float32)
    mu = jnp.mean(tf, axis=-1, keepdims=True)
    var = jnp.mean(jnp.square(tf - mu), axis=-1, keepdims=True)
    y = (tf - mu) * lax.rsqrt(var + EPS)
    return (y * w.astype(jnp.float32) + b.astype(jnp.float32)).astype(t.dtype)


def _rope_tables(seq_len):
    inv = ROPE_THETA ** (-jnp.arange(0, HEAD_DIM, 2, dtype=jnp.float32) / HEAD_DIM)
    ang = jnp.arange(seq_len, dtype=jnp.float32)[:, None] * inv[None, :]
    return jnp.cos(ang), jnp.sin(ang)


def _apply_rope(t, cos, sin):
    tf = t.astype(jnp.float32)
    t1, t2 = jnp.split(tf, 2, axis=-1)
    c_, s_ = cos[None, :, None, :], sin[None, :, None, :]
    return jnp.concatenate([t1 * c_ - t2 * s_, t2 * c_ + t1 * s_], axis=-1).astype(t.dtype)


def _sliding_window_sink_attention(q, k, v, sinks):
    B, S, _, dh = q.shape
    nb = S // BLOCK
    G = N_Q_HEADS // N_KV_HEADS
    qb = q.reshape(B, nb, BLOCK, N_KV_HEADS, G, dh)

    def band(t):
        tb = t.reshape(B, nb, BLOCK, N_KV_HEADS, dh)
        prev = jnp.concatenate([jnp.zeros_like(tb[:, :1]), tb[:, :-1]], axis=1)
        return jnp.concatenate([prev, tb], axis=2)

    kb, vb = band(k), band(v)
    s = jnp.einsum('bnqhgd,bnkhd->bnhgqk', qb, kb,
                   preferred_element_type=jnp.float32) * (dh ** -0.5)
    qi = jnp.arange(BLOCK)[:, None]
    kj = jnp.arange(2 * BLOCK)[None, :]
    dist = qi + BLOCK - kj
    local = (dist >= 0) & (dist < WINDOW)
    exists = (jnp.arange(nb)[:, None, None] > 0) | (kj[None] >= BLOCK)
    mask = local[None] & exists
    s = jnp.where(mask[None, :, None, None], s, -jnp.inf)
    sink = sinks.astype(jnp.float32).reshape(1, 1, N_KV_HEADS, G, 1, 1)
    m = jnp.maximum(jnp.max(s, axis=-1, keepdims=True), sink)
    p = jnp.exp(s - m)
    p = p / (jnp.sum(p, axis=-1, keepdims=True) + jnp.exp(sink - m))
    o = jnp.einsum('bnhgqk,bnkhd->bnqhgd', p.astype(v.dtype), vb)
    return o.reshape(B, S, N_Q_HEADS * dh)


def _conformer_conv(u, conv_w, conv_b, ln_w, ln_b):
    a, g = jnp.split(u, 2, axis=-1)
    z = a * jax.nn.sigmoid(g)
    z = lax.conv_general_dilated(
        z, conv_w[:, None, :], window_strides=(1,),
        padding=[(CONV_KERNEL - 1, 0)],
        dimension_numbers=('NWC', 'WIO', 'NWC'),
        feature_group_count=CONV_WIDTH) + conv_b
    z = _layer_norm(z, ln_w, ln_b)
    return jax.nn.silu(z)


def setup_inputs(seed: int = 0) -> dict:
    key = jax.random.key(seed)
    ks = jax.random.split(key, 16)
    f32 = jnp.float32
    n = lambda k, shape, s: jax.random.normal(k, shape, f32) * s
    return {
        "x": n(ks[0], (BATCH, SEQ, D_MODEL), 1.0),
        "c": n(ks[1], (BATCH, D_MODEL), 1.0),
        "w_ada": n(ks[2], (DEPTH, D_MODEL, 3 * D_MODEL), 0.5 * D_MODEL ** -0.5),
        "b_ada": n(ks[3], (DEPTH, 3 * D_MODEL), 0.02),
        "norm_w": 1.0 + n(ks[4], (DEPTH, D_MODEL), 0.02),
        "w_in": n(ks[5], (DEPTH, D_MODEL, IN_WIDTH), D_MODEL ** -0.5),
        "q_norm_w": 1.0 + n(ks[6], (DEPTH, HEAD_DIM), 0.02),
        "k_norm_w": 1.0 + n(ks[7], (DEPTH, HEAD_DIM), 0.02),
        "sinks": n(ks[8], (DEPTH, N_Q_HEADS), 0.5),
        "conv_w": n(ks[9], (DEPTH, CONV_KERNEL, CONV_WIDTH), CONV_KERNEL ** -0.5),
        "conv_b": n(ks[10], (DEPTH, CONV_WIDTH), 0.02),
        "ln_w": 1.0 + n(ks[11], (DEPTH, CONV_WIDTH), 0.02),
        "ln_b": n(ks[12], (DEPTH, CONV_WIDTH), 0.02),
        "w_out": n(ks[13], (DEPTH, MIX_WIDTH, D_MODEL), MIX_WIDTH ** -0.5),
    }


def reference(x, c, w_ada, b_ada, norm_w, w_in, q_norm_w, k_norm_w, sinks,
              conv_w, conv_b, ln_w, ln_b, w_out):
    B, S, _ = x.shape
    cos, sin = _rope_tables(S)
    c_act = jax.nn.silu(c)
    splits = (ATTN_WIDTH,
              ATTN_WIDTH + KV_WIDTH,
              ATTN_WIDTH + 2 * KV_WIDTH,
              2 * ATTN_WIDTH + 2 * KV_WIDTH,
              2 * ATTN_WIDTH + 2 * KV_WIDTH + 2 * CONV_WIDTH)
    for l in range(DEPTH):
        shift, scale, gate = jnp.split(c_act @ w_ada[l] + b_ada[l], 3, axis=-1)
        h = _rms_norm(x, norm_w[l]) * (1.0 + scale[:, None, :]) + shift[:, None, :]
        proj = h @ w_in[l]
        q, k, v, gate_a, u, gate_b = jnp.split(proj, splits, axis=-1)
        q = q.reshape(B, S, N_Q_HEADS, HEAD_DIM)
        k = k.reshape(B, S, N_KV_HEADS, HEAD_DIM)
        v = v.reshape(B, S, N_KV_HEADS, HEAD_DIM)
        q = _apply_rope(_rms_norm(q, q_norm_w[l]), cos, sin)
        k = _apply_rope(_rms_norm(k, k_norm_w[l]), cos, sin)
        y_a = _sliding_window_sink_attention(q, k, v, sinks[l]) * jax.nn.silu(gate_a)
        y_b = _conformer_conv(u, conv_w[l], conv_b[l], ln_w[l], ln_b[l]) * jax.nn.silu(gate_b)
        y = jnp.concatenate([y_a, y_b], axis=-1) @ w_out[l]
        x = x + gate[:, None, :] * y
    return x
```

```cpp
#include <hip/hip_runtime.h>
#include <hip/hip_cooperative_groups.h>
#include <cstdio>
namespace cg = cooperative_groups;
namespace pg8 {
#define PG8_LAS __attribute__((address_space(3)))
typedef unsigned short bf16_t;
typedef short bf16x8 __attribute__((ext_vector_type(8)));
typedef float f32x4 __attribute__((ext_vector_type(4)));
typedef unsigned u32x4 __attribute__((ext_vector_type(4)));
constexpr int BM = 256, BK = 64, HALF = 128, HTB = HALF * BK * 2  , STAGE_BYTES = 8 * HTB, NXCD = 8, WGM = 8;

__host__ __device__ __forceinline__ int lds_byte(int r, int c) { const int st = (r >> 4) * 2 + (c >> 5), rr = r & 15, cc = c & 31, ob = rr * 64 + cc * 2; return st * 1024 + (ob ^ (((ob >> 9) & 1) << 5)); }
__host__ __device__ __forceinline__ void stage_rc(int b, int& R, int& C) { const int st = b / 1024, sb = b % 1024, swz = sb ^ (((sb >> 9) & 1) << 5); R = (st >> 1) * 16 + swz / 64; C = (st & 1) * 32 + (swz % 64) / 2; }
__host__ __device__ __forceinline__ int perm32(int rho) { const int n = rho >> 4, i = rho & 15; return 8 * (i >> 2) + 4 * n + (i & 3); }

struct Unit { int pm, pn; };
struct Gemm { const bf16_t* A; const bf16_t* Bt; int M, N, K; };

struct StaticOrder {
    int nM, nN, nwg, G, c;
    __host__ __device__ void init(int M, int N, int G_, int c_) { nM = M / BM; nN = N / BM; nwg = nM * nN; G = G_; c = c_; }
    __host__ __device__ bool next(int i, Unit& u) const {
        const long L = (long)i * G + c; if (L >= nwg) return false;
        int wgid = (int)L; { const int q = nwg / NXCD, r = nwg % NXCD, xcd = wgid % NXCD, off = wgid / NXCD; wgid = (xcd < r ? xcd * (q + 1) : r * (q + 1) + (xcd - r) * q) + off; }
        const int nig = WGM * nN, gid = wgid / nig, fm = gid * WGM, gsz = (nM - fm) < WGM ? (nM - fm) : WGM;
        u.pm = fm + ((wgid % nig) % gsz); u.pn = (wgid % nig) / gsz; return true;
    }
    __device__ __forceinline__ void a_ready(const Unit&) const {}
    __device__ __forceinline__ void done(const Unit&) const {}
};
__device__ __forceinline__ unsigned cvt_pk_bf16(float lo, float hi) { unsigned r; asm volatile("v_cvt_pk_bf16_f32 %0, %1, %2" : "=v"(r) : "v"(lo), "v"(hi)); return r; }
template <class Epi, class Sched, bool STAMP = false>
__device__ __forceinline__ void gemm_phase(PG8_LAS unsigned char* lds, const Gemm g, const Sched& S, const Epi& E, unsigned long long* stamps) {
    const int tid = threadIdx.x, wid = __builtin_amdgcn_readfirstlane(tid >> 6), lane = tid & 63, wr = wid >> 2, wc = wid & 3, fr = lane & 15, fq = lane >> 4;
    const int K = g.K, nt = K / BK;
    int ts_lo = 0, ts_hi = 0, nts = 0; const unsigned long long rt_entry = STAMP ? (unsigned long long)wall_clock64() : 0ull;
#define PG8_STAMP() do { if (STAMP && wid == 0 && nts < 64) { const unsigned long long _c = (unsigned long long)clock64(); \
        ts_lo = (lane == nts) ? (int)(unsigned)_c : ts_lo; ts_hi = (lane == nts) ? (int)(unsigned)(_c >> 32) : ts_hi; ++nts; } } while (0)
    PG8_STAMP();
    unsigned voffA[2], voffB[2];
#pragma unroll
    for (int i = 0; i < 2; ++i) { int R, C; stage_rc(tid * 16 + i * 8192, R, C); const int Rb = Epi::PERM ? ((R & ~31) + perm32(R & 31)) : R;
        voffA[i] = (unsigned)(R * K + C) * 2u; voffB[i] = (unsigned)(Rb * K + C) * 2u; }
    const size_t kstep = (size_t)(BK * 2);
    const size_t hstep = (size_t)HALF * K * 2;
    const size_t tstep = 2 * hstep;
    const unsigned ldsw = (unsigned)wid * 1024u;
    const int aoff = lds_byte(wr * 64 + fr, fq * 8), boff = lds_byte(wc * 32 + fr, fq * 8);
#define PG8_SA(b, h) (((b) * 2 + (h)) * HTB)
#define PG8_SB(b, h) ((4 + (b) * 2 + (h)) * HTB)
#define PG8_STAGE(bufoff, gbase, voff) do { _Pragma("unroll") for (int _i = 0; _i < 2; ++_i) \
        __builtin_amdgcn_global_load_lds((const unsigned*)((const char*)(gbase) + (voff)[_i]), (PG8_LAS unsigned*)(lds + (bufoff) + ldsw + _i * 8192), 16, 0, 0); } while (0)
#define PG8_LDA(dst, b, h) do { _Pragma("unroll") for (int m = 0; m < 4; ++m) _Pragma("unroll") for (int k = 0; k < 2; ++k) dst[m][k] = *(const PG8_LAS bf16x8*)(lds + PG8_SA(b, h) + aoff + m * 2048 + k * 1024); } while (0)
#define PG8_LDB(dst, b, h) do { _Pragma("unroll") for (int n = 0; n < 2; ++n) _Pragma("unroll") for (int k = 0; k < 2; ++k) dst[n][k] = *(const PG8_LAS bf16x8*)(lds + PG8_SB(b, h) + boff + n * 2048 + k * 1024); } while (0)
#define PG8_MMA(ai, bj, At, Bt) do { __builtin_amdgcn_s_setprio(1); _Pragma("unroll") for (int m = 0; m < 4; ++m) _Pragma("unroll") for (int n = 0; n < 2; ++n) _Pragma("unroll") for (int k = 0; k < 2; ++k) \
        acc[ai][bj][m][n] = __builtin_amdgcn_mfma_f32_16x16x32_bf16(Bt[n][k], At[m][k], acc[ai][bj][m][n], 0, 0, 0); __builtin_amdgcn_s_setprio(0); } while (0)
#define PG8_WAIT_V(n) asm volatile("s_waitcnt vmcnt(" #n ")" ::: "memory")
#define PG8_WAIT_L(n) asm volatile("s_waitcnt lgkmcnt(" #n ")" ::: "memory")
#define PG8_BAR __builtin_amdgcn_s_barrier()
#define PG8_SCHED __builtin_amdgcn_sched_barrier(0)
    Unit cur, nxt; int ui = 0;
    if (!S.next(0, cur)) return;
    f32x4 acc[2][2][4][2];
#pragma unroll
    for (int a = 0; a < 2; ++a)
#pragma unroll
        for (int b = 0; b < 2; ++b)
#pragma unroll
            for (int m = 0; m < 4; ++m)
#pragma unroll
                for (int n = 0; n < 2; ++n) acc[a][b][m][n] = (f32x4){0.f, 0.f, 0.f, 0.f};
    bf16x8 At[4][2], B0[2][2], B1[2][2];
    const char* cA = (const char*)g.A + (size_t)cur.pm * tstep; const char* cB = (const char*)g.Bt + (size_t)cur.pn * tstep;
    S.a_ready(cur);
    PG8_STAGE(PG8_SB(0, 0), cB, voffB); PG8_STAGE(PG8_SA(0, 0), cA, voffA); PG8_STAGE(PG8_SB(0, 1), cB + hstep, voffB); PG8_STAGE(PG8_SA(0, 1), cA + hstep, voffA);
    if (wr == 1) PG8_BAR;
    PG8_WAIT_V(4); PG8_BAR;
    PG8_STAGE(PG8_SB(1, 0), cB + kstep, voffB); PG8_STAGE(PG8_SA(1, 0), cA + kstep, voffA); PG8_STAGE(PG8_SB(1, 1), cB + hstep + kstep, voffB);
    PG8_WAIT_V(6); PG8_BAR;
    PG8_STAMP();
    for (;;) {
        const bool has_next = S.next(ui + 1, nxt);
        const char* nA = has_next ? (const char*)g.A + (size_t)nxt.pm * tstep : cA; const char* nB = has_next ? (const char*)g.Bt + (size_t)nxt.pn * tstep : cB;
        for (int t = 0; t < nt; t += 2) {
            const bool last = (t == nt - 2);
            const char* a1 = cA + (size_t)(t + 1) * kstep;
            const char* a2 = last ? nA : cA + (size_t)(t + 2) * kstep; const char* b2 = last ? nB : cB + (size_t)(t + 2) * kstep;
            const char* a3 = a2 + kstep; const char* b3 = b2 + kstep;
            if (last && has_next) S.a_ready(nxt);
            PG8_LDB(B0, 0, 0); PG8_SCHED; PG8_LDA(At, 0, 0); PG8_STAGE(PG8_SA(1, 1), a1 + hstep, voffA);
            PG8_WAIT_L(8); PG8_BAR; PG8_WAIT_L(0); PG8_MMA(0, 0, At, B0); PG8_BAR; PG8_SCHED;
            PG8_LDB(B1, 0, 1); PG8_STAGE(PG8_SB(0, 0), b2, voffB);
            PG8_BAR; PG8_WAIT_L(0); PG8_MMA(0, 1, At, B1); PG8_BAR;
            PG8_LDA(At, 0, 1); PG8_STAGE(PG8_SA(0, 0), a2, voffA);
            PG8_BAR; PG8_WAIT_L(0); PG8_MMA(1, 0, At, B0); PG8_BAR; PG8_SCHED;
            PG8_STAGE(PG8_SB(0, 1), b2 + hstep, voffB);
            PG8_WAIT_V(6); PG8_BAR; PG8_MMA(1, 1, At, B1); PG8_BAR;
            PG8_LDB(B0, 1, 0); PG8_SCHED; PG8_LDA(At, 1, 0); PG8_STAGE(PG8_SA(0, 1), a2 + hstep, voffA);
            PG8_WAIT_L(8); PG8_BAR; PG8_WAIT_L(0); PG8_MMA(0, 0, At, B0); PG8_BAR; PG8_SCHED;
            PG8_LDB(B1, 1, 1); PG8_STAGE(PG8_SB(1, 0), b3, voffB);
            PG8_BAR; PG8_WAIT_L(0); PG8_MMA(0, 1, At, B1); PG8_BAR;
            PG8_LDA(At, 1, 1); PG8_STAGE(PG8_SA(1, 0), a3, voffA);
            PG8_BAR; PG8_WAIT_L(0); PG8_MMA(1, 0, At, B0); PG8_BAR; PG8_SCHED;
            PG8_STAGE(PG8_SB(1, 1), b3 + hstep, voffB);
            PG8_WAIT_V(6); PG8_BAR; PG8_MMA(1, 1, At, B1); PG8_BAR;
        }
        PG8_STAMP();
        if constexpr (!Epi::AFTER_DRAIN) { E(acc, cur, wr, wc, fr, fq); S.done(cur); }
        PG8_STAMP();
        if (!has_next) break;
#pragma unroll
        for (int a = 0; a < 2; ++a)
#pragma unroll
            for (int b = 0; b < 2; ++b)
#pragma unroll
                for (int m = 0; m < 4; ++m)
#pragma unroll
                    for (int n = 0; n < 2; ++n) acc[a][b][m][n] = (f32x4){0.f, 0.f, 0.f, 0.f};
        cur = nxt; cA = nA; cB = nB; ++ui;
    }
    PG8_WAIT_V(0);
    if (wr == 0) PG8_BAR;
    PG8_BAR;
    if constexpr (Epi::AFTER_DRAIN) { E.fused(acc, cur, wr, wc, fr, fq, lds, wid, lane); S.done(cur); }
    PG8_STAMP();
    if (STAMP && wid == 0) { stamps[lane] = lane < nts ? (((unsigned long long)(unsigned)ts_hi << 32) | (unsigned)ts_lo) : 0ull;
        if (lane == 62) stamps[62] = rt_entry; if (lane == 63) stamps[63] = (unsigned long long)wall_clock64(); }
#undef PG8_STAMP
#undef PG8_SA
#undef PG8_SB
#undef PG8_STAGE
#undef PG8_LDA
#undef PG8_LDB
#undef PG8_MMA
#undef PG8_WAIT_V
#undef PG8_WAIT_L
#undef PG8_BAR
#undef PG8_SCHED
}
}
namespace pg8 {
struct EpiProj {
    static constexpr bool PERM = true, AFTER_DRAIN = false;
    bf16_t* O; int ldc;
    __device__ __forceinline__ void operator()(const f32x4 (&acc)[2][2][4][2], const Unit& u, int wr, int wc, int fr, int fq) const {
        const int row0 = u.pm * BM + wr * 64 + fr, col0 = u.pn * BM + wc * 32 + 8 * fq;
#pragma unroll
        for (int ai = 0; ai < 2; ++ai)
#pragma unroll
            for (int m = 0; m < 4; ++m) { bf16_t* rowp = O + (size_t)(row0 + ai * HALF + m * 16) * ldc + col0;
#pragma unroll
                for (int bj = 0; bj < 2; ++bj) { const f32x4 v0 = acc[ai][bj][m][0], v1 = acc[ai][bj][m][1];
                    u32x4 w; w.x = cvt_pk_bf16(v0[0], v0[1]); w.y = cvt_pk_bf16(v0[2], v0[3]); w.z = cvt_pk_bf16(v1[0], v1[1]); w.w = cvt_pk_bf16(v1[2], v1[3]);
                    *(u32x4*)(rowp + bj * HALF) = w; } }
    }
};
struct EpiOut {
    static constexpr bool PERM = false, AFTER_DRAIN = false;
    const float* X; float* C; const float* mod;
    __device__ __forceinline__ void operator()(const f32x4 (&acc)[2][2][4][2], const Unit& u, int wr, int wc, int fr, int fq) const {
        const int row0 = u.pm * BM + wr * 64 + fr, col0 = u.pn * BM + wc * 32 + 4 * fq;
        const float* gp = mod + (size_t)(u.pm >> 3) * 3072 + 2048 + col0;
        f32x4 gv[2][2];
#pragma unroll
        for (int bj = 0; bj < 2; ++bj)
#pragma unroll
            for (int n = 0; n < 2; ++n) gv[bj][n] = *(const f32x4*)(gp + bj * HALF + n * 16);
#pragma unroll
        for (int ai = 0; ai < 2; ++ai)
#pragma unroll
            for (int m = 0; m < 4; ++m) { const size_t off = (size_t)(row0 + ai * HALF + m * 16) * 1024 + col0;
#pragma unroll
                for (int bj = 0; bj < 2; ++bj)
#pragma unroll
                    for (int n = 0; n < 2; ++n) { const f32x4 xs = *(const f32x4*)(X + off + bj * HALF + n * 16);
                        *(f32x4*)(C + off + bj * HALF + n * 16) = xs + gv[bj][n] * acc[ai][bj][m][n]; }
                asm volatile("" ::: "memory"); }
    }
};
}
#define LAS __attribute__((address_space(3)))
typedef unsigned short bf16_t;
typedef float f32x2 __attribute__((ext_vector_type(2)));
typedef float f32x4 __attribute__((ext_vector_type(4)));
typedef float f32x16 __attribute__((ext_vector_type(16)));
typedef short bf16x8 __attribute__((ext_vector_type(8)));
typedef short s16x4 __attribute__((ext_vector_type(4)));
typedef unsigned u32x2 __attribute__((ext_vector_type(2)));
typedef unsigned u32x4 __attribute__((ext_vector_type(4)));
typedef __bf16 bf16x2_t __attribute__((ext_vector_type(2)));

constexpr int DM = 1024, NBATCH = 8, SEQ = 2048, MTOK = NBATCH * SEQ, INW = 2816;
constexpr int OFF_Q = 0, OFF_K = 512, OFF_V = 640, OFF_GA = 768, OFF_UA = 1280, OFF_UG = 1792, OFF_GB = 2304;
constexpr float EPS = 1e-6f;
constexpr size_t MiB = 1u << 20;
constexpr size_t WS_CTL = 0, CTL_BYTES = 64 * 1024;
constexpr size_t WS_MOD = 1 * MiB;
constexpr size_t WS_ROPE = 2 * MiB;
constexpr size_t WS_WINT = 4 * MiB;
constexpr size_t WS_WOUTT = 10 * MiB;
constexpr size_t WS_H = 16 * MiB;
constexpr size_t WS_PROJ = 48 * MiB;
constexpr size_t WS_Y = 144 * MiB;
constexpr size_t WS_END = 176 * MiB;
constexpr int RING_BYTES = 131072, MISC_OFF = RING_BYTES + 320, LDS_BYTES = 147456;

__device__ __forceinline__ float bflo(unsigned w) { return __uint_as_float(w << 16); }
__device__ __forceinline__ float bfhi(unsigned w) { return __uint_as_float(w & 0xffff0000u); }
__device__ __forceinline__ unsigned pk(float lo, float hi) { f32x2 v = {lo, hi}; bf16x2_t b = __builtin_convertvector(v, bf16x2_t); return __builtin_bit_cast(unsigned, b); }
__device__ __forceinline__ float wave_sum(float v) {
#pragma unroll
    for (int o = 1; o < 64; o <<= 1) v += __shfl_xor(v, o);
    return v;
}
__device__ __forceinline__ float silu_f(float v) { return v / (1.0f + __expf(-v)); }
#define LDS_WAIT() asm volatile("s_waitcnt lgkmcnt(0)" ::: "memory")

struct Params {
    const float *x, *c, *w_ada, *b_ada, *norm_w, *w_in, *q_norm_w, *k_norm_w, *sinks, *conv_w, *conv_b, *ln_w, *ln_b, *w_out;
    float* out; unsigned char* ws; int never; int pad;
};
#define XB_TMO      128
#define XB_XCNT(j)  (256  + 64 * (j))
#define XB_XSUB(j)  (1280 + 64 * (j))
#define XB_XGEN(j)  (2304 + 64 * (j))
#define XB_TOP      3328
#define XB_TOPGEN   3392
#define XCD_BAR_WORDS 3456
#define XB_SPIN_CAP (1u << 18)

__device__ __forceinline__ unsigned xb_ld(unsigned* p)              { return __hip_atomic_load(p, __ATOMIC_RELAXED, __HIP_MEMORY_SCOPE_AGENT); }
__device__ __forceinline__ unsigned xb_add(unsigned* p, unsigned v) { return __hip_atomic_fetch_add(p, v, __ATOMIC_RELAXED, __HIP_MEMORY_SCOPE_AGENT); }
__device__ __forceinline__ unsigned xb_xcc_id() { return (unsigned)__builtin_amdgcn_s_getreg((3 << 11) | 20) & 0xFu; }
#define XB_SPIN(cond, bar) do { unsigned _sp = 0; while (cond) { __builtin_amdgcn_s_sleep(1); \
    if ((++_sp & 255u) == 0u) { if (xb_ld(&(bar)[XB_TMO])) break; if (_sp > XB_SPIN_CAP) { atomicAdd(&(bar)[XB_TMO], 1u); break; } } } } while (0)

struct XcdBarrier {
    unsigned* bar; unsigned x;
    volatile LAS unsigned* st;
};

__device__ __forceinline__ XcdBarrier xcd_barrier_post(unsigned* bar, volatile LAS unsigned* st) {
    XcdBarrier b; b.bar = bar; b.x = xb_xcc_id(); b.st = st;
    if (threadIdx.x == 0) (void)xb_add(&bar[XB_XCNT(b.x)], 1u);
    return b;
}
__device__ __forceinline__ void xcd_barrier_complete(unsigned* bar, unsigned x, unsigned& nloc, unsigned& nx) {
    const unsigned G = gridDim.x * gridDim.y * gridDim.z;
    unsigned sum, cnt, mine, sp = 0u;
    for (;;) {
        sum = 0u; cnt = 0u; mine = 0u;
#pragma unroll
        for (unsigned j = 0; j < 16; ++j) { const unsigned c = xb_ld(&bar[XB_XCNT(j)]); sum += c; cnt += (c > 0u) ? 1u : 0u; mine = (j == x) ? c : mine; }
        if (sum == G) break;
        __builtin_amdgcn_s_sleep(1);
        if ((++sp & 255u) == 0u) { if (xb_ld(&bar[XB_TMO])) break; if (sp > XB_SPIN_CAP) { atomicAdd(&bar[XB_TMO], 1u); break; } }
    }
    nloc = mine > 0u ? mine : 1u; nx = cnt > 0u ? cnt : 1u;
}

__device__ __forceinline__ void xcd_barrier(const XcdBarrier& b) {
    asm volatile("s_waitcnt vmcnt(0)" ::: "memory");
    __syncthreads();
    if (threadIdx.x == 0) {
        unsigned* bar = b.bar;
        __builtin_amdgcn_s_waitcnt(0);
        unsigned nloc = b.st[0], nx = b.st[1];
        if (nloc == 0u) { xcd_barrier_complete(bar, b.x, nloc, nx); b.st[0] = nloc; b.st[1] = nx; }
        const unsigned old = xb_add(&bar[XB_XSUB(b.x)], 1u);
        const unsigned gen = old / nloc;
        if (old + 1u == (gen + 1u) * nloc) {
            __builtin_amdgcn_fence(__ATOMIC_RELEASE, "agent");
            asm volatile("s_waitcnt vmcnt(0)" ::: "memory");
            const unsigned og = xb_add(&bar[XB_TOP], 1u);
            const unsigned tg = og / nx;
            if (og + 1u == (tg + 1u) * nx) xb_add(&bar[XB_TOPGEN], 1u);
            else XB_SPIN(xb_ld(&bar[XB_TOPGEN]) == tg, bar);
            __builtin_amdgcn_fence(__ATOMIC_ACQUIRE, "agent");
            xb_add(&bar[XB_XGEN(b.x)], 1u);
            asm volatile("s_waitcnt vmcnt(0)" ::: "memory");
        } else {
            XB_SPIN(xb_ld(&bar[XB_XGEN(b.x)]) == gen, bar);
            __builtin_amdgcn_fence(__ATOMIC_ACQUIRE, "agent");
            asm volatile("s_waitcnt vmcnt(0)" ::: "memory");
        }
    }
    __syncthreads();
}
__device__ __forceinline__ void p0_transpose_item(const float* W, int K, int N, bf16_t* WT, LAS float* scr, int item, int lane) {
    const int nblk = N / 32, kb = item / nblk, nb = item % nblk, k0 = 64 * kb, n0 = 32 * nb;
#pragma unroll 8
    for (int i = 0; i < 32; ++i) { const int kk = 2 * i + (lane >> 5); scr[kk * 33 + (lane & 31)] = W[(size_t)(k0 + kk) * N + n0 + (lane & 31)]; }
    LDS_WAIT(); asm volatile("" ::: "memory");
    const int c = lane & 7;
#pragma unroll
    for (int j = 0; j < 4; ++j) { const int n = (lane >> 3) + 8 * j; const LAS float* s = scr + (8 * c) * 33 + n;
        u32x4 o; o.x = pk(s[0 * 33], s[1 * 33]); o.y = pk(s[2 * 33], s[3 * 33]); o.z = pk(s[4 * 33], s[5 * 33]); o.w = pk(s[6 * 33], s[7 * 33]);
        *(u32x4*)(WT + (size_t)(n0 + n) * K + k0 + 8 * c) = o; }
    LDS_WAIT(); asm volatile("" ::: "memory");
}

__device__ __forceinline__ void phase0(const Params& p, LAS unsigned char* lds, int tid, int wave, int lane) {
    float* mod = (float*)(p.ws + WS_MOD);
    for (int item = blockIdx.x; item < 192; item += gridDim.x) {
        LAS float* cact = (LAS float*)lds;
        LAS float* red = (LAS float*)(lds + 32768);
        for (int i = tid; i < 8192; i += 512) cact[i] = silu_f(p.c[i]);
        __syncthreads();
        const int n0 = item * 16, kk = lane >> 2, c4 = lane & 3;
        float acc[8][4];
#pragma unroll
        for (int b = 0; b < 8; ++b)
#pragma unroll
            for (int j = 0; j < 4; ++j) acc[b][j] = 0.f;
#pragma unroll
        for (int i = 0; i < 8; ++i) {
            const int k = wave * 128 + i * 16 + kk;
            const f32x4 wv = *(const f32x4*)(p.w_ada + (size_t)k * 3072 + n0 + 4 * c4);
#pragma unroll
            for (int b = 0; b < 8; ++b) { const float ca = cact[b * 1024 + k];
                acc[b][0] += ca * wv.x; acc[b][1] += ca * wv.y; acc[b][2] += ca * wv.z; acc[b][3] += ca * wv.w; }
        }
#pragma unroll
        for (int b = 0; b < 8; ++b)
#pragma unroll
            for (int j = 0; j < 4; ++j) { float v = acc[b][j];
#pragma unroll
                for (int o = 4; o < 64; o <<= 1) v += __shfl_xor(v, o);
                acc[b][j] = v; }
        if (lane < 4) {
#pragma unroll
            for (int b = 0; b < 8; ++b)
#pragma unroll
                for (int j = 0; j < 4; ++j) red[(wave * 8 + b) * 16 + 4 * lane + j] = acc[b][j];
        }
        __syncthreads();
        if (tid < 128) { const int b = tid >> 4, col = tid & 15; float s = p.b_ada[n0 + col];
#pragma unroll
            for (int w = 0; w < 8; ++w) s += red[(w * 8 + b) * 16 + col];
            mod[b * 3072 + n0 + col] = s; }
        __syncthreads();
    }
    {
        LAS float* scr = (LAS float*)(lds + wave * 16384);
        const int NGW = gridDim.x * 8, gw = NGW - 1 - ((int)blockIdx.x * 8 + wave);
        constexpr int I_IN = (DM / 64) * (INW / 32), I_OUT = (DM / 64) * (DM / 32);
        for (int it = gw; it < I_IN + I_OUT; it += NGW) {
            if (it < I_IN) p0_transpose_item(p.w_in, DM, INW, (bf16_t*)(p.ws + WS_WINT), scr, it, lane);
            else p0_transpose_item(p.w_out, DM, DM, (bf16_t*)(p.ws + WS_WOUTT), scr, it - I_IN, lane);
        }
    }
    for (int idx = blockIdx.x * 512 + tid; idx < SEQ * 32; idx += gridDim.x * 512) {
        const int pos = idx >> 5, i = idx & 31;
        const float inv = exp2f(-(float)i * 0.41524101186092033f);
        const float ang = (float)pos * inv;
        double t = (double)ang * 0.15915494309189535; t -= __builtin_floor(t);
        const float tf = (float)t;
        f32x2 cs; cs.x = __builtin_amdgcn_cosf(tf); cs.y = __builtin_amdgcn_sinf(tf);
        ((f32x2*)(p.ws + WS_ROPE))[idx] = cs;
    }
}

__device__ __forceinline__ void phase1(const Params& p, int wave, int lane) {
    const float* mod = (const float*)(p.ws + WS_MOD);
    bf16_t* H = (bf16_t*)(p.ws + WS_H);
    for (int rb = blockIdx.x; rb < MTOK / 64; rb += gridDim.x) {
        const int b = rb >> 5;
        f32x4 g[4], sh[4];
#pragma unroll
        for (int j = 0; j < 4; ++j) { const int k = 4 * lane + 256 * j;
            const f32x4 nw = *(const f32x4*)(p.norm_w + k), sc = *(const f32x4*)(mod + b * 3072 + 1024 + k);
            g[j] = nw * (sc + 1.0f); sh[j] = *(const f32x4*)(mod + b * 3072 + k); }
#pragma unroll 2
        for (int r = 0; r < 8; ++r) {
            const size_t row = (size_t)rb * 64 + wave * 8 + r;
            const f32x4* xr = (const f32x4*)(p.x + row * DM) + lane;
            f32x4 v[4]; float s = 0.f;
#pragma unroll
            for (int j = 0; j < 4; ++j) { v[j] = xr[64 * j]; s += (v[j].x * v[j].x + v[j].y * v[j].y) + (v[j].z * v[j].z + v[j].w * v[j].w); }
            const float rstd = rsqrtf(wave_sum(s) * (1.0f / DM) + EPS);
            u32x2* o8 = (u32x2*)(H + row * DM) + lane;
#pragma unroll
            for (int j = 0; j < 4; ++j) { const f32x4 hv = v[j] * rstd * g[j] + sh[j]; u32x2 w; w.x = pk(hv.x, hv.y); w.y = pk(hv.z, hv.w); o8[64 * j] = w; }
        }
    }
}

constexpr int KS_STRIDE = 144, VT_STRIDE = 520, VT_OFF = 256 * KS_STRIDE;
__device__ __forceinline__ void attn_unit(const Params& p, LAS unsigned char* lds, int unit, int tid, int wave, int lane) {
    const bf16_t* proj = (const bf16_t*)(p.ws + WS_PROJ);
    bf16_t* Y = (bf16_t*)(p.ws + WS_Y);
    const f32x2* rope = (const f32x2*)(p.ws + WS_ROPE);
    const int hk = unit & 1, n = (unit >> 1) & 15, b = unit >> 5;
    LAS unsigned char* Ks = lds;
    LAS unsigned char* Vt = lds + VT_OFF;
    {
        const int key = tid >> 1, hf = tid & 1, pos = n * 128 - 128 + key;
        u32x4 o0 = {0u, 0u, 0u, 0u}, o1 = o0, o2 = o0, o3 = o0;
        if (pos >= 0) {
            const bf16_t* kr = proj + (size_t)(b * SEQ + pos) * INW + OFF_K + hk * 64 + 16 * hf;
            const u32x4 a0 = *(const u32x4*)(kr), a1 = *(const u32x4*)(kr + 8), b0 = *(const u32x4*)(kr + 32), b1 = *(const u32x4*)(kr + 40);
            float lo[16], hi[16];
#pragma unroll
            for (int e = 0; e < 4; ++e) { lo[2 * e] = bflo(a0[e]); lo[2 * e + 1] = bfhi(a0[e]); lo[8 + 2 * e] = bflo(a1[e]); lo[8 + 2 * e + 1] = bfhi(a1[e]);
                                          hi[2 * e] = bflo(b0[e]); hi[2 * e + 1] = bfhi(b0[e]); hi[8 + 2 * e] = bflo(b1[e]); hi[8 + 2 * e + 1] = bfhi(b1[e]); }
            float ss = 0.f;
#pragma unroll
            for (int e = 0; e < 16; ++e) ss += lo[e] * lo[e] + hi[e] * hi[e];
            ss += __shfl_xor(ss, 1);
            const float rstd = rsqrtf(ss * (1.0f / 64.0f) + EPS);
            const f32x2* cs = rope + pos * 32 + 16 * hf;
            const float* kw = p.k_norm_w + 16 * hf;
#pragma unroll
            for (int e = 0; e < 16; ++e) { const f32x2 c = cs[e]; const float a = lo[e] * rstd * kw[e], bb = hi[e] * rstd * kw[32 + e];
                lo[e] = a * c.x - bb * c.y; hi[e] = bb * c.x + a * c.y; }
#pragma unroll
            for (int e = 0; e < 4; ++e) { o0[e] = pk(lo[2 * e], lo[2 * e + 1]); o1[e] = pk(lo[8 + 2 * e], lo[8 + 2 * e + 1]); o2[e] = pk(hi[2 * e], hi[2 * e + 1]); o3[e] = pk(hi[8 + 2 * e], hi[8 + 2 * e + 1]); }
        }
        LAS unsigned char* kd = Ks + key * KS_STRIDE + 32 * hf;
        *(LAS u32x4*)(kd) = o0; *(LAS u32x4*)(kd + 16) = o1; *(LAS u32x4*)(kd + 64) = o2; *(LAS u32x4*)(kd + 80) = o3;
    }
    {
        const int kp = tid & 127, dg = tid >> 7, pos = n * 128 - 128 + 2 * kp;
        u32x4 a0 = {0u, 0u, 0u, 0u}, a1 = a0, b0 = a0, b1 = a0;
        if (pos >= 0) {
            const bf16_t* vr = proj + (size_t)(b * SEQ + pos) * INW + OFF_V + hk * 64 + 16 * dg;
            a0 = *(const u32x4*)(vr); a1 = *(const u32x4*)(vr + 8); b0 = *(const u32x4*)(vr + INW); b1 = *(const u32x4*)(vr + INW + 8);
        }
        LAS unsigned char* vd = Vt + (16 * dg) * VT_STRIDE + 4 * kp;
#pragma unroll
        for (int e = 0; e < 4; ++e) {
            *(LAS unsigned*)(vd + (2 * e) * VT_STRIDE) = (a0[e] & 0xffffu) | (b0[e] << 16);
            *(LAS unsigned*)(vd + (2 * e + 1) * VT_STRIDE) = (a0[e] >> 16) | (b0[e] & 0xffff0000u);
            *(LAS unsigned*)(vd + (8 + 2 * e) * VT_STRIDE) = (a1[e] & 0xffffu) | (b1[e] << 16);
            *(LAS unsigned*)(vd + (8 + 2 * e + 1) * VT_STRIDE) = (a1[e] >> 16) | (b1[e] & 0xffff0000u);
        }
    }
    __syncthreads();
    const int head = hk * 4 + (wave >> 1), qh = wave & 1, q = lane & 31, h = lane >> 5;
    constexpr float LOG2E = 1.4426950408889634f;
    const float sink2 = p.sinks[head] * LOG2E;
#pragma unroll 1
    for (int sub = 0; sub < 2; ++sub) {
        const int i0 = 64 * qh + 32 * sub, kt0 = 2 * qh + sub;
        const int pos = n * 128 + i0 + q;
        const size_t row = (size_t)b * SEQ + pos;
        bf16x8 Qf[4];
        {
            const bf16_t* qr = proj + row * INW + OFF_Q + head * 64 + 8 * h;
            float qf[4][8]; float ss = 0.f;
#pragma unroll
            for (int s = 0; s < 4; ++s) { const u32x4 raw = *(const u32x4*)(qr + 16 * s);
#pragma unroll
                for (int e = 0; e < 4; ++e) { qf[s][2 * e] = bflo(raw[e]); qf[s][2 * e + 1] = bfhi(raw[e]); } }
#pragma unroll
            for (int s = 0; s < 4; ++s)
#pragma unroll
                for (int j = 0; j < 8; ++j) ss += qf[s][j] * qf[s][j];
            ss += __shfl_xor(ss, 32);
            const float rstd = rsqrtf(ss * (1.0f / 64.0f) + EPS) * (0.125f * LOG2E);
#pragma unroll
            for (int s = 0; s < 2; ++s) {
                const int d0 = 16 * s + 8 * h;
                const f32x2* cs = rope + pos * 32 + d0;
                const float* qw = p.q_norm_w + d0;
#pragma unroll
                for (int j = 0; j < 8; ++j) { const f32x2 c = cs[j]; const float a = qf[s][j] * rstd * qw[j], bb = qf[s + 2][j] * rstd * qw[32 + j];
                    qf[s][j] = a * c.x - bb * c.y; qf[s + 2][j] = bb * c.x + a * c.y; }
            }
#pragma unroll
            for (int s = 0; s < 4; ++s) { u32x4 w; w.x = pk(qf[s][0], qf[s][1]); w.y = pk(qf[s][2], qf[s][3]); w.z = pk(qf[s][4], qf[s][5]); w.w = pk(qf[s][6], qf[s][7]);
                Qf[s] = __builtin_bit_cast(bf16x8, w); }
        }
        f32x16 S[5];
#pragma unroll
        for (int t = 0; t < 5; ++t) {
#pragma unroll
            for (int r = 0; r < 16; ++r) S[t][r] = 0.f;
            const LAS unsigned char* kb = Ks + (32 * (kt0 + t) + q) * KS_STRIDE + 16 * h;
#pragma unroll
            for (int s = 0; s < 4; ++s) { const bf16x8 kf = *(const LAS bf16x8*)(kb + 32 * s);
                S[t] = __builtin_amdgcn_mfma_f32_32x32x16_bf16(kf, Qf[s], S[t], 0, 0, 0); }
        }
        float m = sink2;
#pragma unroll
        for (int t = 0; t < 5; ++t)
#pragma unroll
            for (int r = 0; r < 16; ++r) {
                const int keyrow = (r & 3) + 8 * (r >> 2) + 4 * h;
                const int dist = 32 * t + keyrow - q;
                const bool valid = (dist > 0) && (dist <= 128) && (n > 0 || 32 * (kt0 + t) + keyrow >= 128);
                const float sv = valid ? S[t][r] : -1e30f;
                S[t][r] = sv; m = fmaxf(m, sv);
            }
        m = fmaxf(m, __shfl_xor(m, 32));
        float l = 0.f;
#pragma unroll
        for (int t = 0; t < 5; ++t)
#pragma unroll
            for (int r = 0; r < 16; ++r) { const float pv = exp2f(S[t][r] - m); S[t][r] = pv; l += pv; }
        l += __shfl_xor(l, 32);
        const float inv = 1.0f / (l + exp2f(sink2 - m));
        f32x16 O[2];
#pragma unroll
        for (int dt = 0; dt < 2; ++dt)
#pragma unroll
            for (int r = 0; r < 16; ++r) O[dt][r] = 0.f;
#pragma unroll
        for (int t = 0; t < 5; ++t)
#pragma unroll
            for (int s2 = 0; s2 < 2; ++s2) {
                u32x4 w; w.x = pk(S[t][8 * s2 + 0], S[t][8 * s2 + 1]); w.y = pk(S[t][8 * s2 + 2], S[t][8 * s2 + 3]); w.z = pk(S[t][8 * s2 + 4], S[t][8 * s2 + 5]); w.w = pk(S[t][8 * s2 + 6], S[t][8 * s2 + 7]);
                const bf16x8 pb = __builtin_bit_cast(bf16x8, w);
#pragma unroll
                for (int dt = 0; dt < 2; ++dt) {
                    const LAS unsigned char* vb = Vt + (32 * dt + q) * VT_STRIDE + 2 * (32 * (kt0 + t) + 16 * s2 + 4 * h);
                    const u32x2 v0 = *(const LAS u32x2*)(vb), v1 = *(const LAS u32x2*)(vb + 16);
                    u32x4 vv; vv.x = v0.x; vv.y = v0.y; vv.z = v1.x; vv.w = v1.y;
                    O[dt] = __builtin_amdgcn_mfma_f32_32x32x16_bf16(__builtin_bit_cast(bf16x8, vv), pb, O[dt], 0, 0, 0);
                }
            }
        const bf16_t* gr = proj + row * INW + OFF_GA + head * 64 + 4 * h;
        bf16_t* yr = Y + row * DM + head * 64 + 4 * h;
#pragma unroll
        for (int dt = 0; dt < 2; ++dt)
#pragma unroll
            for (int g4 = 0; g4 < 4; ++g4) {
                const int d = 32 * dt + 8 * g4;
                const u32x2 gw = *(const u32x2*)(gr + d);
                const float o0 = O[dt][4 * g4 + 0] * inv * silu_f(bflo(gw.x)), o1 = O[dt][4 * g4 + 1] * inv * silu_f(bfhi(gw.x));
                const float o2 = O[dt][4 * g4 + 2] * inv * silu_f(bflo(gw.y)), o3 = O[dt][4 * g4 + 3] * inv * silu_f(bfhi(gw.y));
                u32x2 w; w.x = pk(o0, o1); w.y = pk(o2, o3);
                *(u32x2*)(yr + d) = w;
            }
    }
    __syncthreads();
}

constexpr int CO_OFF = 62 * 1024;
__device__ __forceinline__ void conv_unit(const Params& p, LAS unsigned char* lds, int unit, int tid, int wave, int lane) {
    const bf16_t* proj = (const bf16_t*)(p.ws + WS_PROJ);
    bf16_t* Y = (bf16_t*)(p.ws + WS_Y);
    const int b = unit >> 5;
    const size_t rowbase = (size_t)b * SEQ;
    const int cp = tid & 255, sh = tid >> 8;
    const f32x4 lw0 = *(const f32x4*)(p.ln_w + 8 * lane), lw1 = *(const f32x4*)(p.ln_w + 8 * lane + 4);
    const f32x4 lb0 = *(const f32x4*)(p.ln_b + 8 * lane), lb1 = *(const f32x4*)(p.ln_b + 8 * lane + 4);
#pragma unroll 1
    for (int hh = 0; hh < 2; ++hh) {
        const int T0 = (unit & 31) * 64 + 32 * hh;
        for (int ch = tid; ch < 62 * 64; ch += 512) {
            const int rel = ch >> 6, c8 = ch & 63, pos = T0 - 30 + rel;
            u32x4 o = {0u, 0u, 0u, 0u};
            if (pos >= 0) {
                const bf16_t* r = proj + (rowbase + pos) * INW + 8 * c8;
                const u32x4 a = *(const u32x4*)(r + OFF_UA), g = *(const u32x4*)(r + OFF_UG);
#pragma unroll
                for (int e = 0; e < 4; ++e) { const float z0 = bflo(a[e]) / (1.0f + __expf(-bflo(g[e]))), z1 = bfhi(a[e]) / (1.0f + __expf(-bfhi(g[e]))); o[e] = pk(z0, z1); }
            }
            *(LAS u32x4*)(lds + rel * 1024 + 16 * c8) = o;
        }
        __syncthreads();
        {
            float w0[31], w1[31];
#pragma unroll
            for (int j = 0; j < 31; ++j) { const f32x2 w = *(const f32x2*)(p.conv_w + j * 512 + 2 * cp); w0[j] = w.x; w1[j] = w.y; }
            const f32x2 bz = *(const f32x2*)(p.conv_b + 2 * cp);
            float a0[16], a1[16];
#pragma unroll
            for (int t = 0; t < 16; ++t) { a0[t] = bz.x; a1[t] = bz.y; }
            const LAS unsigned char* zb = lds + (16 * sh) * 1024 + 4 * cp;
#pragma unroll
            for (int r = 0; r < 46; ++r) {
                const unsigned zz = *(const LAS unsigned*)(zb + r * 1024);
                const float z0 = bflo(zz), z1 = bfhi(zz);
#pragma unroll
                for (int t = 0; t < 16; ++t) { const int j = r - t; if (j >= 0 && j <= 30) { a0[t] = fmaf(w0[j], z0, a0[t]); a1[t] = fmaf(w1[j], z1, a1[t]); } }
            }
            LAS unsigned char* cb = lds + CO_OFF + (16 * sh) * 2048 + 8 * cp;
#pragma unroll
            for (int t = 0; t < 16; ++t) { f32x2 v = {a0[t], a1[t]}; *(LAS f32x2*)(cb + t * 2048) = v; }
        }
        __syncthreads();
#pragma unroll 2
        for (int r = 0; r < 4; ++r) {
            const int tl = wave * 4 + r; const size_t row = rowbase + T0 + tl;
            f32x4 v0 = *(const LAS f32x4*)(lds + CO_OFF + tl * 2048 + 32 * lane), v1 = *(const LAS f32x4*)(lds + CO_OFF + tl * 2048 + 32 * lane + 16);
            const u32x4 gb = *(const u32x4*)(proj + row * INW + OFF_GB + 8 * lane);
            const float mean = wave_sum((v0.x + v0.y) + (v0.z + v0.w) + (v1.x + v1.y) + (v1.z + v1.w)) * (1.0f / 512.0f);
            v0 = v0 - mean; v1 = v1 - mean;
            const float var = wave_sum((v0.x * v0.x + v0.y * v0.y) + (v0.z * v0.z + v0.w * v0.w) + (v1.x * v1.x + v1.y * v1.y) + (v1.z * v1.z + v1.w * v1.w)) * (1.0f / 512.0f);
            const float rstd = rsqrtf(var + EPS);
            v0 = v0 * rstd * lw0 + lb0; v1 = v1 * rstd * lw1 + lb1;
            u32x4 o;
            o.x = pk(silu_f(v0.x) * silu_f(bflo(gb.x)), silu_f(v0.y) * silu_f(bfhi(gb.x)));
            o.y = pk(silu_f(v0.z) * silu_f(bflo(gb.y)), silu_f(v0.w) * silu_f(bfhi(gb.y)));
            o.z = pk(silu_f(v1.x) * silu_f(bflo(gb.z)), silu_f(v1.y) * silu_f(bfhi(gb.z)));
            o.w = pk(silu_f(v1.z) * silu_f(bflo(gb.w)), silu_f(v1.w) * silu_f(bfhi(gb.w)));
            *(u32x4*)(Y + row * DM + 512 + 8 * lane) = o;
        }
    }
    __syncthreads();
}

__global__ void __launch_bounds__(512, 2) fwd_kernel(Params p) {
    extern __shared__ __attribute__((aligned(16))) unsigned char lds_raw[];
    LAS unsigned char* lds = (LAS unsigned char*)lds_raw;
    const int tid = threadIdx.x, lane = tid & 63, wave = __builtin_amdgcn_readfirstlane(tid >> 6);
    for (int u = tid; u < (LDS_BYTES - RING_BYTES) / 4; u += 512) ((LAS unsigned*)(lds + RING_BYTES))[u] = 0u;
    __syncthreads();
    XcdBarrier bar = xcd_barrier_post((unsigned*)(p.ws + WS_CTL), (volatile LAS unsigned*)(lds + MISC_OFF) + 8);
    if (p.never) cg::this_grid().sync();

#ifndef NO_P0
    phase0(p, lds, tid, wave, lane);
#endif
    xcd_barrier(bar);
#ifndef NO_P1
    phase1(p, wave, lane);
#endif
    xcd_barrier(bar);
#ifndef NO_P2
    {
        pg8::Gemm g{(const bf16_t*)(p.ws + WS_H), (const bf16_t*)(p.ws + WS_WINT), MTOK, INW, DM};
        pg8::StaticOrder S; S.init(MTOK, INW, (int)gridDim.x, (int)blockIdx.x);
        pg8::EpiProj E{(bf16_t*)(p.ws + WS_PROJ), INW};
        pg8::gemm_phase<pg8::EpiProj, pg8::StaticOrder>(lds, g, S, E, nullptr);
    }
#endif
    xcd_barrier(bar);
#ifndef NO_P3A
    for (int u = blockIdx.x; u < 256; u += gridDim.x) attn_unit(p, lds, u, tid, wave, lane);
#endif
#ifndef NO_P3B
    for (int u = blockIdx.x; u < 256; u += gridDim.x) conv_unit(p, lds, u, tid, wave, lane);
#endif
    xcd_barrier(bar);
#ifndef NO_P4
    {
        pg8::Gemm g{(const bf16_t*)(p.ws + WS_Y), (const bf16_t*)(p.ws + WS_WOUTT), MTOK, DM, DM};
        pg8::StaticOrder S; S.init(MTOK, DM, (int)gridDim.x, (int)blockIdx.x);
        pg8::EpiOut E{p.x, p.out, (const float*)(p.ws + WS_MOD)};
        pg8::gemm_phase<pg8::EpiOut, pg8::StaticOrder>(lds, g, S, E, nullptr);
    }
#endif
}

extern "C" void kernel_launch(void* const* d_in, const int* in_sizes, int n_in, void* d_out, int out_size, void* d_ws, size_t ws_size, hipStream_t stream) {
    static int grid = 0;
    if (grid == 0) {
        if (n_in != 14 || out_size != MTOK * DM || ws_size < WS_END) { fprintf(stderr, "kernel_launch: unexpected shapes (n_in %d, out %d, ws %zu)\n", n_in, out_size, ws_size); grid = -1; return; }
        int dev = 0, cus = 0, per_cu = 0;
        (void)hipGetDevice(&dev);
        (void)hipDeviceGetAttribute(&cus, hipDeviceAttributeMultiprocessorCount, dev);
        if (hipFuncSetAttribute((const void*)fwd_kernel, hipFuncAttributeMaxDynamicSharedMemorySize, LDS_BYTES) != hipSuccess) { fprintf(stderr, "kernel_launch: hipFuncSetAttribute failed\n"); grid = -1; return; }
        if (hipOccupancyMaxActiveBlocksPerMultiprocessor(&per_cu, (const void*)fwd_kernel, 512, LDS_BYTES) != hipSuccess || per_cu < 1) { fprintf(stderr, "kernel_launch: occupancy query says %d\n", per_cu); per_cu = 1; }
        (void)hipGetLastError();
        grid = cus > 0 ? cus : 256;
        if (grid > 256) grid = 256;
    }
    if (grid < 0) return;
    (void)hipMemsetAsync((char*)d_ws + WS_CTL, 0, CTL_BYTES, stream);
    Params p{};
    const float** pp = (const float**)&p;
    for (int i = 0; i < 14; ++i) pp[i] = (const float*)d_in[i];
    p.out = (float*)d_out; p.ws = (unsigned char*)d_ws; p.never = 0; p.pad = 0;
    void* args[] = {&p};
    const hipError_t e = hipLaunchCooperativeKernel((const void*)fwd_kernel, dim3(grid), dim3(512), args, LDS_BYTES, stream);
    if (e != hipSuccess) fprintf(stderr, "kernel_launch: cooperative launch failed: %s (grid %d)\n", hipGetErrorString(e), grid);
}
```

```cpp
#include <hip/hip_runtime.h>
#include <hip/hip_cooperative_groups.h>
#include <cstdio>
namespace cg = cooperative_groups;
#define GEMM_ALIGN true
#define GEMM_SP2 true
namespace pg8 {
#define PG8_LAS __attribute__((address_space(3)))
typedef unsigned short bf16_t;
typedef short bf16x8 __attribute__((ext_vector_type(8)));
typedef float f32x4 __attribute__((ext_vector_type(4)));
typedef unsigned u32x4 __attribute__((ext_vector_type(4)));
constexpr int BM = 256, BK = 64, HALF = 128, HTB = HALF * BK * 2  , STAGE_BYTES = 8 * HTB, NXCD = 8, WGM = 8;

__host__ __device__ __forceinline__ int lds_byte(int r, int c) { const int st = (r >> 4) * 2 + (c >> 5), rr = r & 15, cc = c & 31, ob = rr * 64 + cc * 2; return st * 1024 + (ob ^ (((ob >> 9) & 1) << 5)); }
__host__ __device__ __forceinline__ void stage_rc(int b, int& R, int& C) { const int st = b / 1024, sb = b % 1024, swz = sb ^ (((sb >> 9) & 1) << 5); R = (st >> 1) * 16 + swz / 64; C = (st & 1) * 32 + (swz % 64) / 2; }
__host__ __device__ __forceinline__ int perm32(int rho) { const int n = rho >> 4, i = rho & 15; return 8 * (i >> 2) + 4 * n + (i & 3); }

struct Unit { int pm, pn; };
struct Gemm { const bf16_t* A; const bf16_t* Bt; int M, N, K; };

struct StaticOrder {
    int nM, nN, nwg, G, c;
    __host__ __device__ void init(int M, int N, int G_, int c_) { nM = M / BM; nN = N / BM; nwg = nM * nN; G = G_; c = c_; }
    __host__ __device__ bool next(int i, Unit& u) const {
        const long L = (long)i * G + c; if (L >= nwg) return false;
        int wgid = (int)L; { const int q = nwg / NXCD, r = nwg % NXCD, xcd = wgid % NXCD, off = wgid / NXCD; wgid = (xcd < r ? xcd * (q + 1) : r * (q + 1) + (xcd - r) * q) + off; }
        const int nig = WGM * nN, gid = wgid / nig, fm = gid * WGM, gsz = (nM - fm) < WGM ? (nM - fm) : WGM;
        u.pm = fm + ((wgid % nig) % gsz); u.pn = (wgid % nig) / gsz; return true;
    }
    __device__ __forceinline__ void a_ready(const Unit&) const {}
    __device__ __forceinline__ void done(const Unit&) const {}
};
__device__ __forceinline__ unsigned cvt_pk_bf16(float lo, float hi) { unsigned r; asm volatile("v_cvt_pk_bf16_f32 %0, %1, %2" : "=v"(r) : "v"(lo), "v"(hi)); return r; }
template <class Epi, class Sched, bool ALIGN_EPI = false, bool SP2 = false>
__device__ __forceinline__ void gemm_phase(PG8_LAS unsigned char* lds, const Gemm g, const Sched& S, const Epi& E) {
    const int tid = threadIdx.x, wid = __builtin_amdgcn_readfirstlane(tid >> 6), lane = tid & 63, wr = wid >> 2, wc = wid & 3, fr = lane & 15, fq = lane >> 4;
    const int K = g.K, nt = K / BK;
    unsigned voffA[2], voffB[2];
#pragma unroll
    for (int i = 0; i < 2; ++i) { int R, C; stage_rc(tid * 16 + i * 8192, R, C); const int Rb = Epi::PERM ? ((R & ~31) + perm32(R & 31)) : R;
        voffA[i] = (unsigned)(R * K + C) * 2u; voffB[i] = (unsigned)(Rb * K + C) * 2u; }
    const size_t kstep = (size_t)(BK * 2);
    const size_t hstep = (size_t)HALF * K * 2;
    const size_t tstep = 2 * hstep;
    const unsigned ldsw = (unsigned)wid * 1024u;
    const int aoff = lds_byte(wr * 64 + fr, fq * 8), boff = lds_byte(wc * 32 + fr, fq * 8);
#define PG8_SA(b, h) (((b) * 2 + (h)) * HTB)
#define PG8_SB(b, h) ((4 + (b) * 2 + (h)) * HTB)
#define PG8_STAGE(bufoff, gbase, voff) do { _Pragma("unroll") for (int _i = 0; _i < 2; ++_i) \
        __builtin_amdgcn_global_load_lds((const unsigned*)((const char*)(gbase) + (voff)[_i]), (PG8_LAS unsigned*)(lds + (bufoff) + ldsw + _i * 8192), 16, 0, 0); } while (0)
#define PG8_LDA(dst, b, h) do { _Pragma("unroll") for (int m = 0; m < 4; ++m) _Pragma("unroll") for (int k = 0; k < 2; ++k) dst[m][k] = *(const PG8_LAS bf16x8*)(lds + PG8_SA(b, h) + aoff + m * 2048 + k * 1024); } while (0)
#define PG8_LDB(dst, b, h) do { _Pragma("unroll") for (int n = 0; n < 2; ++n) _Pragma("unroll") for (int k = 0; k < 2; ++k) dst[n][k] = *(const PG8_LAS bf16x8*)(lds + PG8_SB(b, h) + boff + n * 2048 + k * 1024); } while (0)
#define PG8_MMA(ai, bj, At, Bt) do { __builtin_amdgcn_s_setprio(1); _Pragma("unroll") for (int m = 0; m < 4; ++m) _Pragma("unroll") for (int n = 0; n < 2; ++n) _Pragma("unroll") for (int k = 0; k < 2; ++k) \
        acc[ai][bj][m][n] = __builtin_amdgcn_mfma_f32_16x16x32_bf16(Bt[n][k], At[m][k], acc[ai][bj][m][n], 0, 0, 0); __builtin_amdgcn_s_setprio(0); } while (0)
#define PG8_WAIT_V(n) asm volatile("s_waitcnt vmcnt(" #n ")" ::: "memory")
#define PG8_WAIT_L(n) asm volatile("s_waitcnt lgkmcnt(" #n ")" ::: "memory")
#define PG8_BAR __builtin_amdgcn_s_barrier()
#define PG8_SCHED __builtin_amdgcn_sched_barrier(0)
    Unit cur, nxt; int ui = 0;
    if (!S.next(0, cur)) return;
    f32x4 acc[2][2][4][2];
#pragma unroll
    for (int a = 0; a < 2; ++a)
#pragma unroll
        for (int b = 0; b < 2; ++b)
#pragma unroll
            for (int m = 0; m < 4; ++m)
#pragma unroll
                for (int n = 0; n < 2; ++n) acc[a][b][m][n] = (f32x4){0.f, 0.f, 0.f, 0.f};
    bf16x8 At[4][2], B0[2][2], B1[2][2];
    const char* cA = (const char*)g.A + (size_t)cur.pm * tstep; const char* cB = (const char*)g.Bt + (size_t)cur.pn * tstep;
    S.a_ready(cur);
    if constexpr (SP2) {
        PG8_STAGE(PG8_SB(0, 0), cB, voffB); PG8_STAGE(PG8_SB(0, 1), cB + hstep, voffB); PG8_STAGE(PG8_SA(0, 0), cA, voffA); PG8_STAGE(PG8_SA(0, 1), cA + hstep, voffA);
        if (wr == 1) PG8_BAR;
        PG8_WAIT_V(2); PG8_BAR;
        PG8_STAGE(PG8_SB(1, 0), cB + kstep, voffB); PG8_STAGE(PG8_SA(1, 0), cA + kstep, voffA); PG8_STAGE(PG8_SB(1, 1), cB + hstep + kstep, voffB);
        PG8_WAIT_V(6); PG8_BAR;
    } else {
        PG8_STAGE(PG8_SB(0, 0), cB, voffB); PG8_STAGE(PG8_SA(0, 0), cA, voffA); PG8_STAGE(PG8_SB(0, 1), cB + hstep, voffB); PG8_STAGE(PG8_SA(0, 1), cA + hstep, voffA);
        if (wr == 1) PG8_BAR;
        PG8_WAIT_V(4); PG8_BAR;
        PG8_STAGE(PG8_SB(1, 0), cB + kstep, voffB); PG8_STAGE(PG8_SA(1, 0), cA + kstep, voffA); PG8_STAGE(PG8_SB(1, 1), cB + hstep + kstep, voffB);
        PG8_WAIT_V(6); PG8_BAR;
    }
    for (;;) {
        const bool has_next = S.next(ui + 1, nxt);
        const char* nA = has_next ? (const char*)g.A + (size_t)nxt.pm * tstep : cA; const char* nB = has_next ? (const char*)g.Bt + (size_t)nxt.pn * tstep : cB;
        for (int t = 0; t < nt; t += 2) {
            const bool last = (t == nt - 2);
            const char* a1 = cA + (size_t)(t + 1) * kstep;
            const char* a2 = last ? nA : cA + (size_t)(t + 2) * kstep; const char* b2 = last ? nB : cB + (size_t)(t + 2) * kstep;
            const char* a3 = a2 + kstep; const char* b3 = b2 + kstep;
            if (last && has_next) S.a_ready(nxt);
            if constexpr (SP2) {
            PG8_LDB(B0, 0, 0); PG8_LDB(B1, 0, 1); PG8_SCHED; PG8_LDA(At, 0, 0); PG8_STAGE(PG8_SA(1, 1), a1 + hstep, voffA);
            PG8_WAIT_V(8); PG8_WAIT_L(0); PG8_BAR; PG8_MMA(0, 0, At, B0); PG8_MMA(0, 1, At, B1); PG8_BAR; PG8_SCHED;
            PG8_LDA(At, 0, 1); PG8_STAGE(PG8_SB(0, 0), b2, voffB); PG8_STAGE(PG8_SB(0, 1), b2 + hstep, voffB); PG8_STAGE(PG8_SA(0, 0), a2, voffA);
            PG8_WAIT_V(8); PG8_WAIT_L(0); PG8_BAR; PG8_MMA(1, 0, At, B0); PG8_MMA(1, 1, At, B1); PG8_BAR; PG8_SCHED;
            PG8_LDB(B0, 1, 0); PG8_LDB(B1, 1, 1); PG8_SCHED; PG8_LDA(At, 1, 0); PG8_STAGE(PG8_SA(0, 1), a2 + hstep, voffA);
            PG8_WAIT_V(8); PG8_WAIT_L(0); PG8_BAR; PG8_MMA(0, 0, At, B0); PG8_MMA(0, 1, At, B1); PG8_BAR; PG8_SCHED;
            PG8_LDA(At, 1, 1); PG8_STAGE(PG8_SB(1, 0), b3, voffB); PG8_STAGE(PG8_SB(1, 1), b3 + hstep, voffB); PG8_STAGE(PG8_SA(1, 0), a3, voffA);
            PG8_WAIT_V(8); PG8_WAIT_L(0); PG8_BAR; PG8_MMA(1, 0, At, B0); PG8_MMA(1, 1, At, B1); PG8_BAR; PG8_SCHED;
            } else {
            PG8_LDB(B0, 0, 0); PG8_SCHED; PG8_LDA(At, 0, 0); PG8_STAGE(PG8_SA(1, 1), a1 + hstep, voffA);
            PG8_WAIT_L(8); PG8_BAR; PG8_WAIT_L(0); PG8_MMA(0, 0, At, B0); PG8_BAR; PG8_SCHED;
            PG8_LDB(B1, 0, 1); PG8_STAGE(PG8_SB(0, 0), b2, voffB);
            PG8_BAR; PG8_WAIT_L(0); PG8_MMA(0, 1, At, B1); PG8_BAR;
            PG8_LDA(At, 0, 1); PG8_STAGE(PG8_SA(0, 0), a2, voffA);
            PG8_BAR; PG8_WAIT_L(0); PG8_MMA(1, 0, At, B0); PG8_BAR; PG8_SCHED;
            PG8_STAGE(PG8_SB(0, 1), b2 + hstep, voffB);
            PG8_WAIT_V(6); PG8_BAR; PG8_MMA(1, 1, At, B1); PG8_BAR;
            PG8_LDB(B0, 1, 0); PG8_SCHED; PG8_LDA(At, 1, 0); PG8_STAGE(PG8_SA(0, 1), a2 + hstep, voffA);
            PG8_WAIT_L(8); PG8_BAR; PG8_WAIT_L(0); PG8_MMA(0, 0, At, B0); PG8_BAR; PG8_SCHED;
            PG8_LDB(B1, 1, 1); PG8_STAGE(PG8_SB(1, 0), b3, voffB);
            PG8_BAR; PG8_WAIT_L(0); PG8_MMA(0, 1, At, B1); PG8_BAR;
            PG8_LDA(At, 1, 1); PG8_STAGE(PG8_SA(1, 0), a3, voffA);
            PG8_BAR; PG8_WAIT_L(0); PG8_MMA(1, 0, At, B0); PG8_BAR; PG8_SCHED;
            PG8_STAGE(PG8_SB(1, 1), b3 + hstep, voffB);
            PG8_WAIT_V(6); PG8_BAR; PG8_MMA(1, 1, At, B1); PG8_BAR;
            }
        }
        if constexpr (ALIGN_EPI) { if (wr == 0) PG8_BAR; }
        if constexpr (!Epi::AFTER_DRAIN) { E(acc, cur, wr, wc, fr, fq); S.done(cur); }
        if (!has_next) break;
#pragma unroll
        for (int a = 0; a < 2; ++a)
#pragma unroll
            for (int b = 0; b < 2; ++b)
#pragma unroll
                for (int m = 0; m < 4; ++m)
#pragma unroll
                    for (int n = 0; n < 2; ++n) acc[a][b][m][n] = (f32x4){0.f, 0.f, 0.f, 0.f};
        cur = nxt; cA = nA; cB = nB; ++ui;
        if constexpr (ALIGN_EPI) { if (wr == 1) PG8_BAR; }
    }
    PG8_WAIT_V(0);
    if constexpr (!ALIGN_EPI) { if (wr == 0) PG8_BAR; }
    PG8_BAR;
    if constexpr (Epi::AFTER_DRAIN) { E.fused(acc, cur, wr, wc, fr, fq, lds, wid, lane); S.done(cur); }
#undef PG8_SA
#undef PG8_SB
#undef PG8_STAGE
#undef PG8_LDA
#undef PG8_LDB
#undef PG8_MMA
#undef PG8_WAIT_V
#undef PG8_WAIT_L
#undef PG8_BAR
#undef PG8_SCHED
}
}
namespace pg8 {
struct EpiProj {
    static constexpr bool PERM = true, AFTER_DRAIN = false;
    bf16_t* O; int ldc; bf16_t* Z;
    __device__ __forceinline__ void operator()(const f32x4 (&acc)[2][2][4][2], const Unit& u, int wr, int wc, int fr, int fq) const {
        const int row0 = u.pm * BM + wr * 64 + fr;
        if (u.pn >= 5 && u.pn < 9) {
            const int zc = (u.pn - 5) * 128 + wc * 32 + 8 * fq;
#pragma unroll
            for (int ai = 0; ai < 2; ++ai)
#pragma unroll
                for (int m = 0; m < 4; ++m) { bf16_t* zp = Z + (size_t)(row0 + ai * HALF + m * 16) * 512 + zc;
                    const f32x4 a0 = acc[ai][0][m][0], a1 = acc[ai][0][m][1], g0 = acc[ai][1][m][0], g1 = acc[ai][1][m][1];
                    f32x4 z0, z1;
#pragma unroll
                    for (int e = 0; e < 4; ++e) { z0[e] = a0[e] * __builtin_amdgcn_rcpf(1.0f + __builtin_amdgcn_exp2f(g0[e] * -1.4426950408889634f));
                                                  z1[e] = a1[e] * __builtin_amdgcn_rcpf(1.0f + __builtin_amdgcn_exp2f(g1[e] * -1.4426950408889634f)); }
                    u32x4 w; w.x = cvt_pk_bf16(z0[0], z0[1]); w.y = cvt_pk_bf16(z0[2], z0[3]); w.z = cvt_pk_bf16(z1[0], z1[1]); w.w = cvt_pk_bf16(z1[2], z1[3]);
                    *(u32x4*)zp = w; }
            return;
        }
        const int col0 = u.pn * BM + wc * 32 + 8 * fq;
        const bool gate_tile = (u.pn == 3) || (u.pn == 4) || (u.pn >= 9);
#pragma unroll
        for (int ai = 0; ai < 2; ++ai)
#pragma unroll
            for (int m = 0; m < 4; ++m) { bf16_t* rowp = O + (size_t)(row0 + ai * HALF + m * 16) * ldc + col0;
#pragma unroll
                for (int bj = 0; bj < 2; ++bj) { f32x4 v0 = acc[ai][bj][m][0], v1 = acc[ai][bj][m][1];
                    if (gate_tile) {
#pragma unroll
                        for (int e = 0; e < 4; ++e) { v0[e] = v0[e] * __builtin_amdgcn_rcpf(1.0f + __builtin_amdgcn_exp2f(v0[e] * -1.4426950408889634f));
                                                      v1[e] = v1[e] * __builtin_amdgcn_rcpf(1.0f + __builtin_amdgcn_exp2f(v1[e] * -1.4426950408889634f)); } }
                    u32x4 w; w.x = cvt_pk_bf16(v0[0], v0[1]); w.y = cvt_pk_bf16(v0[2], v0[3]); w.z = cvt_pk_bf16(v1[0], v1[1]); w.w = cvt_pk_bf16(v1[2], v1[3]);
                    *(u32x4*)(rowp + bj * HALF) = w; } }
    }
};
struct EpiOut {
    static constexpr bool PERM = false, AFTER_DRAIN = false;
    const float* X; float* C; const float* mod;
    __device__ __forceinline__ void operator()(const f32x4 (&acc)[2][2][4][2], const Unit& u, int wr, int wc, int fr, int fq) const {
        const int row0 = u.pm * BM + wr * 64 + fr, col0 = u.pn * BM + wc * 32 + 4 * fq;
        const float* gp = mod + (size_t)(u.pm >> 3) * 3072 + 2048 + col0;
        const float* xb = X + (size_t)row0 * 1024 + col0; float* cb = C + (size_t)row0 * 1024 + col0;
        f32x4 gv[2][2];
#pragma unroll
        for (int bj = 0; bj < 2; ++bj)
#pragma unroll
            for (int n = 0; n < 2; ++n) gv[bj][n] = *(const f32x4*)(gp + bj * HALF + n * 16);
        constexpr int DEPTH = 4;
        f32x4 xs[DEPTH][2][2];
#pragma unroll
        for (int gi = 0; gi < DEPTH; ++gi) { const size_t off = (size_t)((gi >> 2) * HALF + (gi & 3) * 16) * 1024;
#pragma unroll
            for (int bj = 0; bj < 2; ++bj)
#pragma unroll
                for (int n = 0; n < 2; ++n) xs[gi][bj][n] = __builtin_nontemporal_load((const f32x4*)(xb + off + bj * HALF + n * 16)); }
#pragma unroll
        for (int gi = 0; gi < 8; ++gi) { const int ai = gi >> 2, m = gi & 3; const size_t off = (size_t)(ai * HALF + m * 16) * 1024;
#pragma unroll
            for (int bj = 0; bj < 2; ++bj)
#pragma unroll
                for (int n = 0; n < 2; ++n) __builtin_nontemporal_store(xs[gi % DEPTH][bj][n] + gv[bj][n] * acc[ai][bj][m][n], (f32x4*)(cb + off + bj * HALF + n * 16));
            if (gi + DEPTH < 8) { const int g2 = gi + DEPTH; const size_t off2 = (size_t)((g2 >> 2) * HALF + (g2 & 3) * 16) * 1024;
#pragma unroll
                for (int bj = 0; bj < 2; ++bj)
#pragma unroll
                    for (int n = 0; n < 2; ++n) xs[gi % DEPTH][bj][n] = __builtin_nontemporal_load((const f32x4*)(xb + off2 + bj * HALF + n * 16)); }
        }
    }
};
}
#define LAS __attribute__((address_space(3)))
typedef unsigned short bf16_t;
typedef float f32x2 __attribute__((ext_vector_type(2)));
typedef float f32x4 __attribute__((ext_vector_type(4)));
typedef float f32x16 __attribute__((ext_vector_type(16)));
typedef short bf16x8 __attribute__((ext_vector_type(8)));
typedef short s16x4 __attribute__((ext_vector_type(4)));
typedef unsigned u32x2 __attribute__((ext_vector_type(2)));
typedef unsigned u32x4 __attribute__((ext_vector_type(4)));
typedef __bf16 bf16x2_t __attribute__((ext_vector_type(2)));

constexpr int DM = 1024, NBATCH = 8, SEQ = 2048, MTOK = NBATCH * SEQ, INW = 2816;
constexpr int OFF_Q = 0, OFF_K = 512, OFF_V = 640, OFF_GA = 768, OFF_UA = 1280, OFF_UG = 1792, OFF_GB = 2304;
constexpr float EPS = 1e-6f;
constexpr size_t MiB = 1u << 20;
constexpr size_t WS_CTL = 0, CTL_BYTES = 64 * 1024;
constexpr size_t WS_MOD = 1 * MiB;
constexpr size_t WS_ROPE = 2 * MiB;
constexpr size_t WS_WINT = 4 * MiB;
constexpr size_t WS_WOUTT = 10 * MiB;
constexpr size_t WS_H = 16 * MiB;
constexpr size_t WS_PROJ = 48 * MiB;
constexpr size_t WS_Y = 144 * MiB;
constexpr size_t WS_Z = 176 * MiB;
constexpr size_t WS_END = 192 * MiB;
constexpr int RING_BYTES = 131072, LDS_BYTES = 163840, MISC_OFF = LDS_BYTES - 256, NW_OFF = 161792;

__device__ __forceinline__ float bflo(unsigned w) { return __uint_as_float(w << 16); }
__device__ __forceinline__ float bfhi(unsigned w) { return __uint_as_float(w & 0xffff0000u); }
__device__ __forceinline__ unsigned pk(float lo, float hi) { f32x2 v = {lo, hi}; bf16x2_t b = __builtin_convertvector(v, bf16x2_t); return __builtin_bit_cast(unsigned, b); }
template <int CTRL, int ROWMASK> __device__ __forceinline__ float dpp_f(float v) { return __builtin_bit_cast(float, __builtin_amdgcn_update_dpp(0, __builtin_bit_cast(int, v), CTRL, ROWMASK, 0xf, false)); }
__device__ __forceinline__ float wave_sum(float v) {
    v += dpp_f<0xB1, 0xf>(v);
    v += dpp_f<0x4E, 0xf>(v);
    v += dpp_f<0x141, 0xf>(v);
    v += dpp_f<0x140, 0xf>(v);
    v += dpp_f<0x142, 0xa>(v);
    v += dpp_f<0x143, 0xc>(v);
    return __builtin_bit_cast(float, __builtin_amdgcn_readlane(__builtin_bit_cast(int, v), 63));
}
__device__ __forceinline__ float sigm_f(float v) { return __builtin_amdgcn_rcpf(1.0f + __builtin_amdgcn_exp2f(v * -1.4426950408889634f)); }
__device__ __forceinline__ float silu_f(float v) { return v * sigm_f(v); }
#define LDS_WAIT() asm volatile("s_waitcnt lgkmcnt(0)" ::: "memory")

struct Params {
    const float *x, *c, *w_ada, *b_ada, *norm_w, *w_in, *q_norm_w, *k_norm_w, *sinks, *conv_w, *conv_b, *ln_w, *ln_b, *w_out;
    float* out; unsigned char* ws; int never; int pad;
};
#define XB_TMO      128
#define XB_XCNT(j)  (256  + 64 * (j))
#define XB_XSUB(j)  (1280 + 64 * (j))
#define XB_XGEN(j)  (2304 + 64 * (j))
#define XB_TOP      3328
#define XB_TOPGEN   3392
#define XCD_BAR_WORDS 3456
#define XB_SPIN_CAP (1u << 18)

__device__ __forceinline__ unsigned xb_ld(unsigned* p)              { return __hip_atomic_load(p, __ATOMIC_RELAXED, __HIP_MEMORY_SCOPE_AGENT); }
__device__ __forceinline__ unsigned xb_add(unsigned* p, unsigned v) { return __hip_atomic_fetch_add(p, v, __ATOMIC_RELAXED, __HIP_MEMORY_SCOPE_AGENT); }
__device__ __forceinline__ unsigned xb_xcc_id() { return (unsigned)__builtin_amdgcn_s_getreg((3 << 11) | 20) & 0xFu; }
#define XB_SPIN(cond, bar) do { unsigned _sp = 0; while (cond) { __builtin_amdgcn_s_sleep(1); \
    if ((++_sp & 255u) == 0u) { if (xb_ld(&(bar)[XB_TMO])) break; if (_sp > XB_SPIN_CAP) { atomicAdd(&(bar)[XB_TMO], 1u); break; } } } } while (0)

struct XcdBarrier {
    unsigned* bar; unsigned x;
    volatile LAS unsigned* st;
};

__device__ __forceinline__ XcdBarrier xcd_barrier_post(unsigned* bar, volatile LAS unsigned* st) {
    XcdBarrier b; b.bar = bar; b.x = xb_xcc_id(); b.st = st;
    if (threadIdx.x == 0) (void)xb_add(&bar[XB_XCNT(b.x)], 1u);
    return b;
}
__device__ __forceinline__ void xcd_barrier_complete(unsigned* bar, unsigned x, unsigned& nloc, unsigned& nx) {
    const unsigned G = gridDim.x * gridDim.y * gridDim.z;
    unsigned sum, cnt, mine, sp = 0u;
    for (;;) {
        sum = 0u; cnt = 0u; mine = 0u;
#pragma unroll
        for (unsigned j = 0; j < 16; ++j) { const unsigned c = xb_ld(&bar[XB_XCNT(j)]); sum += c; cnt += (c > 0u) ? 1u : 0u; mine = (j == x) ? c : mine; }
        if (sum == G) break;
        __builtin_amdgcn_s_sleep(1);
        if ((++sp & 255u) == 0u) { if (xb_ld(&bar[XB_TMO])) break; if (sp > XB_SPIN_CAP) { atomicAdd(&bar[XB_TMO], 1u); break; } }
    }
    nloc = mine > 0u ? mine : 1u; nx = cnt > 0u ? cnt : 1u;
}

__device__ __forceinline__ void xcd_barrier(const XcdBarrier& b) {
    asm volatile("s_waitcnt vmcnt(0)" ::: "memory");
    __syncthreads();
    if (threadIdx.x == 0) {
        unsigned* bar = b.bar;
        __builtin_amdgcn_s_waitcnt(0);
        unsigned nloc = b.st[0], nx = b.st[1];
        if (nloc == 0u) { xcd_barrier_complete(bar, b.x, nloc, nx); b.st[0] = nloc; b.st[1] = nx; }
        const unsigned old = xb_add(&bar[XB_XSUB(b.x)], 1u);
        const unsigned gen = old / nloc;
        if (old + 1u == (gen + 1u) * nloc) {
            __builtin_amdgcn_fence(__ATOMIC_RELEASE, "agent");
            asm volatile("s_waitcnt vmcnt(0)" ::: "memory");
            const unsigned og = xb_add(&bar[XB_TOP], 1u);
            const unsigned tg = og / nx;
            if (og + 1u == (tg + 1u) * nx) xb_add(&bar[XB_TOPGEN], 1u);
            else XB_SPIN(xb_ld(&bar[XB_TOPGEN]) == tg, bar);
            __builtin_amdgcn_fence(__ATOMIC_ACQUIRE, "agent");
            xb_add(&bar[XB_XGEN(b.x)], 1u);
            asm volatile("s_waitcnt vmcnt(0)" ::: "memory");
        } else {
            XB_SPIN(xb_ld(&bar[XB_XGEN(b.x)]) == gen, bar);
            __builtin_amdgcn_fence(__ATOMIC_ACQUIRE, "agent");
            asm volatile("s_waitcnt vmcnt(0)" ::: "memory");
        }
    }
    __syncthreads();
}
__device__ __forceinline__ int glu_col(int n0) {
    if (n0 >= OFF_UA && n0 < OFF_UG) { const int ch = n0 - OFF_UA; return OFF_UA + 256 * (ch >> 7) + (ch & 127); }
    if (n0 >= OFF_UG && n0 < OFF_GB) { const int ch = n0 - OFF_UG; return OFF_UA + 256 * (ch >> 7) + 128 + (ch & 127); }
    return n0;
}
__device__ __forceinline__ void p0_transpose_item(const float* W, int K, int N, bf16_t* WT, LAS float* scr, int item, int lane, bool remap) {
    const int nblk = N / 32, kb = item / nblk, nb = item % nblk, k0 = 64 * kb, n0 = 32 * nb, n0o = remap ? glu_col(n0) : n0;
    float tv[32];
#pragma unroll
    for (int i = 0; i < 32; ++i) tv[i] = __builtin_nontemporal_load(W + (size_t)(k0 + 2 * i + (lane >> 5)) * N + n0 + (lane & 31));
#pragma unroll
    for (int i = 0; i < 32; ++i) scr[(2 * i + (lane >> 5)) * 33 + (lane & 31)] = tv[i];
    LDS_WAIT(); asm volatile("" ::: "memory");
    const int c = lane & 7;
#pragma unroll
    for (int j = 0; j < 4; ++j) { const int n = (lane >> 3) + 8 * j; const LAS float* s = scr + (8 * c) * 33 + n;
        u32x4 o; o.x = pk(s[0 * 33], s[1 * 33]); o.y = pk(s[2 * 33], s[3 * 33]); o.z = pk(s[4 * 33], s[5 * 33]); o.w = pk(s[6 * 33], s[7 * 33]);
        *(u32x4*)(WT + (size_t)(n0o + n) * K + k0 + 8 * c) = o; }
    LDS_WAIT(); asm volatile("" ::: "memory");
}

constexpr int MODCNT_WORD = 8192;
constexpr int N_GEMV_ITEMS = 96;
__device__ __forceinline__ void p1_finish(const Params& p, const f32x4 (&v)[8][4], int rb, int wave, int lane) {
    const float* mod = (const float*)(p.ws + WS_MOD);
    bf16_t* H = (bf16_t*)(p.ws + WS_H);
    const int b = rb >> 5;
    f32x4 g[4], sh[4];
#pragma unroll
    for (int j = 0; j < 4; ++j) { const int k = 4 * lane + 256 * j;
        const f32x4 nw = *(const f32x4*)(p.norm_w + k), sc = *(const f32x4*)(mod + b * 3072 + 1024 + k);
        g[j] = nw * (sc + 1.0f); sh[j] = *(const f32x4*)(mod + b * 3072 + k); }
    const size_t row0 = (size_t)rb * 64 + wave * 8;
#pragma unroll
    for (int r = 0; r < 8; ++r) {
        float s = 0.f;
#pragma unroll
        for (int j = 0; j < 4; ++j) s += (v[r][j].x * v[r][j].x + v[r][j].y * v[r][j].y) + (v[r][j].z * v[r][j].z + v[r][j].w * v[r][j].w);
        const float rstd = rsqrtf(wave_sum(s) * (1.0f / DM) + EPS);
        u32x2* o8 = (u32x2*)(H + (row0 + r) * DM) + lane;
#pragma unroll
        for (int j = 0; j < 4; ++j) { const f32x4 hv = v[r][j] * rstd * g[j] + sh[j]; u32x2 w; w.x = pk(hv.x, hv.y); w.y = pk(hv.z, hv.w); __builtin_nontemporal_store(w, o8 + 64 * j); }
    }
}
__device__ __forceinline__ void p1_load(const Params& p, f32x4 (&v)[8][4], int rb, int wave, int lane) {
    const size_t row0 = (size_t)rb * 64 + wave * 8;
#pragma unroll
    for (int r = 0; r < 8; ++r) { const f32x4* xr = (const f32x4*)(p.x + (row0 + r) * DM) + lane;
#pragma unroll
        for (int j = 0; j < 4; ++j) v[r][j] = xr[64 * j]; }
}
__device__ __forceinline__ void phase01(const Params& p, LAS unsigned char* lds, int tid, int wave, int lane) {
    float* mod = (float*)(p.ws + WS_MOD);
    unsigned* modcnt = (unsigned*)(p.ws + WS_CTL) + MODCNT_WORD;
    for (int item = blockIdx.x; item < N_GEMV_ITEMS; item += gridDim.x) {
        LAS float* cact = (LAS float*)lds;
        LAS float* red = (LAS float*)(lds + 32768);
        const int n0 = item * 32, kk = lane >> 3, c4 = lane & 7;
        float cv[16]; f32x4 wv[16];
#pragma unroll
        for (int i = 0; i < 16; ++i) cv[i] = p.c[tid + 512 * i];
#pragma unroll
        for (int i = 0; i < 16; ++i) wv[i] = __builtin_nontemporal_load((const f32x4*)(p.w_ada + (size_t)(wave * 128 + i * 8 + kk) * 3072 + n0 + 4 * c4));
#pragma unroll
        for (int i = 0; i < 16; ++i) cact[tid + 512 * i] = silu_f(cv[i]);
        __syncthreads();
        float acc[8][4];
#pragma unroll
        for (int b = 0; b < 8; ++b)
#pragma unroll
            for (int j = 0; j < 4; ++j) acc[b][j] = 0.f;
#pragma unroll
        for (int i = 0; i < 16; ++i) {
            const int k = wave * 128 + i * 8 + kk;
#pragma unroll
            for (int b = 0; b < 8; ++b) { const float ca = cact[b * 1024 + k];
                acc[b][0] += ca * wv[i].x; acc[b][1] += ca * wv[i].y; acc[b][2] += ca * wv[i].z; acc[b][3] += ca * wv[i].w; }
        }
#pragma unroll
        for (int b = 0; b < 8; ++b)
#pragma unroll
            for (int j = 0; j < 4; ++j) acc[b][j] += dpp_f<0x128, 0xf>(acc[b][j]);
        if ((lane & 15) < 8) {
#pragma unroll
            for (int b = 0; b < 8; ++b)
#pragma unroll
                for (int j = 0; j < 4; ++j) red[((wave * 4 + (lane >> 4)) * 8 + b) * 32 + 4 * (lane & 7) + j] = acc[b][j];
        }
        __syncthreads();
        if (tid < 256) { const int b = tid >> 5, col = tid & 31; float s = p.b_ada[n0 + col];
#pragma unroll
            for (int w = 0; w < 32; ++w) s += red[(w * 8 + b) * 32 + col];
            __hip_atomic_store(mod + b * 3072 + n0 + col, s, __ATOMIC_RELAXED, __HIP_MEMORY_SCOPE_AGENT); }
        asm volatile("s_waitcnt vmcnt(0)" ::: "memory");
        __syncthreads();
        if (tid == 0) __hip_atomic_fetch_add(modcnt, 1u, __ATOMIC_RELAXED, __HIP_MEMORY_SCOPE_AGENT);
    }
    __syncthreads();
    f32x4 xv[8][4];
    const bool has_rows = (int)blockIdx.x < MTOK / 64;
    if (has_rows) p1_load(p, xv, blockIdx.x, wave, lane);
    {
        LAS float* scr = (LAS float*)(lds + wave * 16384);
        constexpr int I_IN = (DM / 64) * (INW / 32), I_OUT = (DM / 64) * (DM / 32);
        const int nfree = (int)gridDim.x - N_GEMV_ITEMS;
        const bool spare = nfree >= 64;
        const int NGW = spare ? nfree * 8 : (int)gridDim.x * 8;
        const int gw = spare ? (((int)blockIdx.x >= N_GEMV_ITEMS) ? ((int)blockIdx.x - N_GEMV_ITEMS) * 8 + wave : (1 << 30)) : ((int)gridDim.x * 8 - 1 - ((int)blockIdx.x * 8 + wave));
        for (int it = gw; it < I_IN + I_OUT; it += NGW) {
            if (it < I_IN) p0_transpose_item(p.w_in, DM, INW, (bf16_t*)(p.ws + WS_WINT), scr, it, lane, true);
            else p0_transpose_item(p.w_out, DM, DM, (bf16_t*)(p.ws + WS_WOUTT), scr, it - I_IN, lane, false);
        }
    }
    for (int idx = blockIdx.x * 512 + tid; idx < SEQ * 32; idx += gridDim.x * 512) {
        const int pos = idx >> 5, i = idx & 31;
        const float inv = exp2f(-(float)i * 0.41524101186092033f);
        const float ang = (float)pos * inv;
        double t = (double)ang * 0.15915494309189535; t -= __builtin_floor(t);
        const float tf = (float)t;
        f32x2 cs; cs.x = __builtin_amdgcn_cosf(tf); cs.y = __builtin_amdgcn_sinf(tf);
        ((f32x2*)(p.ws + WS_ROPE))[idx] = cs;
    }
    if (tid == 0) {
        unsigned sp = 0;
        while (__hip_atomic_load(modcnt, __ATOMIC_RELAXED, __HIP_MEMORY_SCOPE_AGENT) < (unsigned)N_GEMV_ITEMS) { __builtin_amdgcn_s_sleep(2); if (++sp > (1u << 22)) break; }
        __builtin_amdgcn_fence(__ATOMIC_ACQUIRE, "agent");
        asm volatile("s_waitcnt vmcnt(0)" ::: "memory");
    }
    __syncthreads();
    if (has_rows) p1_finish(p, xv, blockIdx.x, wave, lane);
    for (int rb = blockIdx.x + gridDim.x; rb < MTOK / 64; rb += gridDim.x) { p1_load(p, xv, rb, wave, lane); p1_finish(p, xv, rb, wave, lane); }
}

constexpr int KS_STRIDE = 144, VT_STRIDE = 520, VT_OFF = 256 * KS_STRIDE, QS_OFF = VT_OFF + 64 * VT_STRIDE, QS_STRIDE = 144;
__device__ __forceinline__ void attn_unit(const Params& p, LAS unsigned char* lds, int unit, int tid, int wave, int lane) {
    const bf16_t* proj = (const bf16_t*)(p.ws + WS_PROJ);
    bf16_t* Y = (bf16_t*)(p.ws + WS_Y);
    const f32x2* rope = (const f32x2*)(p.ws + WS_ROPE);
    const int hk = unit & 1, n = (unit >> 1) & 15, b = unit >> 5;
    LAS unsigned char* Ks = lds;
    LAS unsigned char* Vt = lds + VT_OFF;
    LAS unsigned char* Qs = lds + QS_OFF;
    constexpr float LOG2E = 1.4426950408889634f;
    {
        const int key = tid >> 1, hf = tid & 1, posk = n * 128 - 128 + key, poskc = max(posk, 0);
        const bf16_t* kr = proj + (size_t)(b * SEQ + poskc) * INW + OFF_K + hk * 64 + 16 * hf;
        const u32x4 ka0 = *(const u32x4*)(kr), ka1 = *(const u32x4*)(kr + 8), kb0 = *(const u32x4*)(kr + 32), kb1 = *(const u32x4*)(kr + 40);
        const f32x4* kcs = (const f32x4*)(rope + poskc * 32 + 16 * hf);
        const LAS f32x4* kwp = (const LAS f32x4*)(lds + NW_OFF + 256 + 64 * hf);
        f32x4 kc[8], kwl[4], kwh[4];
#pragma unroll
        for (int i = 0; i < 8; ++i) kc[i] = kcs[i];
#pragma unroll
        for (int i = 0; i < 4; ++i) { kwl[i] = kwp[i]; kwh[i] = kwp[8 + i]; }
        const int kp = tid & 127, dg = tid >> 7, posv = n * 128 - 128 + 2 * kp, posvc = max(posv, 0);
        const bf16_t* vr = proj + (size_t)(b * SEQ + posvc) * INW + OFF_V + hk * 64 + 16 * dg;
        u32x4 va0 = *(const u32x4*)(vr), va1 = *(const u32x4*)(vr + 8), vb0 = *(const u32x4*)(vr + INW), vb1 = *(const u32x4*)(vr + INW + 8);
        const int qi = tid >> 2, hf2 = (tid >> 1) & 1, gp = tid & 1, posq = n * 128 + qi;
        const bf16_t* qr = proj + (size_t)(b * SEQ + posq) * INW + OFF_Q + (hk * 4 + 2 * gp) * 64 + 16 * hf2;
        u32x4 qa[2][4];
#pragma unroll
        for (int gg = 0; gg < 2; ++gg) { qa[gg][0] = *(const u32x4*)(qr + gg * 64); qa[gg][1] = *(const u32x4*)(qr + gg * 64 + 8); qa[gg][2] = *(const u32x4*)(qr + gg * 64 + 32); qa[gg][3] = *(const u32x4*)(qr + gg * 64 + 40); }
        {
            float lo[16], hi[16];
#pragma unroll
            for (int e = 0; e < 4; ++e) { lo[2 * e] = bflo(ka0[e]); lo[2 * e + 1] = bfhi(ka0[e]); lo[8 + 2 * e] = bflo(ka1[e]); lo[8 + 2 * e + 1] = bfhi(ka1[e]);
                                          hi[2 * e] = bflo(kb0[e]); hi[2 * e + 1] = bfhi(kb0[e]); hi[8 + 2 * e] = bflo(kb1[e]); hi[8 + 2 * e + 1] = bfhi(kb1[e]); }
            float ss = 0.f;
#pragma unroll
            for (int e = 0; e < 16; ++e) ss += lo[e] * lo[e] + hi[e] * hi[e];
            ss += __shfl_xor(ss, 1);
            const float rstd = posk >= 0 ? rsqrtf(ss * (1.0f / 64.0f) + EPS) : 0.f;
#pragma unroll
            for (int e = 0; e < 16; ++e) { const float cx = kc[e >> 1][2 * (e & 1)], cy = kc[e >> 1][2 * (e & 1) + 1];
                const float a = lo[e] * rstd * kwl[e >> 2][e & 3], bb = hi[e] * rstd * kwh[e >> 2][e & 3];
                lo[e] = a * cx - bb * cy; hi[e] = bb * cx + a * cy; }
            u32x4 o0, o1, o2, o3;
#pragma unroll
            for (int e = 0; e < 4; ++e) { o0[e] = pk(lo[2 * e], lo[2 * e + 1]); o1[e] = pk(lo[8 + 2 * e], lo[8 + 2 * e + 1]); o2[e] = pk(hi[2 * e], hi[2 * e + 1]); o3[e] = pk(hi[8 + 2 * e], hi[8 + 2 * e + 1]); }
            LAS unsigned char* kd = Ks + key * KS_STRIDE + 32 * hf;
            *(LAS u32x4*)(kd) = o0; *(LAS u32x4*)(kd + 16) = o1; *(LAS u32x4*)(kd + 64) = o2; *(LAS u32x4*)(kd + 80) = o3;
        }
        {
            if (posv < 0) { const u32x4 z = {0u, 0u, 0u, 0u}; va0 = z; va1 = z; vb0 = z; vb1 = z; }
            LAS unsigned char* vd = Vt + (16 * dg) * VT_STRIDE + 4 * kp;
#pragma unroll
            for (int e = 0; e < 4; ++e) {
                *(LAS unsigned*)(vd + (2 * e) * VT_STRIDE) = (va0[e] & 0xffffu) | (vb0[e] << 16);
                *(LAS unsigned*)(vd + (2 * e + 1) * VT_STRIDE) = (va0[e] >> 16) | (vb0[e] & 0xffff0000u);
                *(LAS unsigned*)(vd + (8 + 2 * e) * VT_STRIDE) = (va1[e] & 0xffffu) | (vb1[e] << 16);
                *(LAS unsigned*)(vd + (8 + 2 * e + 1) * VT_STRIDE) = (va1[e] >> 16) | (vb1[e] & 0xffff0000u);
            }
        }
        asm volatile("" ::: "memory");
        const f32x4* qcs = (const f32x4*)(rope + posq * 32 + 16 * hf2);
        const LAS f32x4* qwp = (const LAS f32x4*)(lds + NW_OFF + 64 * hf2);
        f32x4 qc[8], qwl[4], qwh[4];
#pragma unroll
        for (int i = 0; i < 8; ++i) qc[i] = qcs[i];
#pragma unroll
        for (int i = 0; i < 4; ++i) { qwl[i] = qwp[i]; qwh[i] = qwp[8 + i]; }
#pragma unroll
        for (int gg = 0; gg < 2; ++gg) {
            float lo[16], hi[16];
#pragma unroll
            for (int e = 0; e < 4; ++e) { lo[2 * e] = bflo(qa[gg][0][e]); lo[2 * e + 1] = bfhi(qa[gg][0][e]); lo[8 + 2 * e] = bflo(qa[gg][1][e]); lo[8 + 2 * e + 1] = bfhi(qa[gg][1][e]);
                                          hi[2 * e] = bflo(qa[gg][2][e]); hi[2 * e + 1] = bfhi(qa[gg][2][e]); hi[8 + 2 * e] = bflo(qa[gg][3][e]); hi[8 + 2 * e + 1] = bfhi(qa[gg][3][e]); }
            float ss = 0.f;
#pragma unroll
            for (int e = 0; e < 16; ++e) ss += lo[e] * lo[e] + hi[e] * hi[e];
            ss += __shfl_xor(ss, 2);
            const float rstd = rsqrtf(ss * (1.0f / 64.0f) + EPS) * (0.125f * LOG2E);
#pragma unroll
            for (int e = 0; e < 16; ++e) { const float cx = qc[e >> 1][2 * (e & 1)], cy = qc[e >> 1][2 * (e & 1) + 1];
                const float a = lo[e] * rstd * qwl[e >> 2][e & 3], bb = hi[e] * rstd * qwh[e >> 2][e & 3];
                lo[e] = a * cx - bb * cy; hi[e] = bb * cx + a * cy; }
            u32x4 o0, o1, o2, o3;
#pragma unroll
            for (int e = 0; e < 4; ++e) { o0[e] = pk(lo[2 * e], lo[2 * e + 1]); o1[e] = pk(lo[8 + 2 * e], lo[8 + 2 * e + 1]); o2[e] = pk(hi[2 * e], hi[2 * e + 1]); o3[e] = pk(hi[8 + 2 * e], hi[8 + 2 * e + 1]); }
            LAS unsigned char* qd = Qs + ((2 * gp + gg) * 128 + qi) * QS_STRIDE + 32 * hf2;
            *(LAS u32x4*)(qd) = o0; *(LAS u32x4*)(qd + 16) = o1; *(LAS u32x4*)(qd + 64) = o2; *(LAS u32x4*)(qd + 80) = o3;
        }
    }
    __syncthreads();
    const int g = wave >> 1, head = hk * 4 + g, qh = wave & 1, q = lane & 31, h = lane >> 5;
    const float sink2 = p.sinks[head] * LOG2E;
    bf16x8 Qf2[2][4];
#pragma unroll
    for (int sub = 0; sub < 2; ++sub) {
        const LAS unsigned char* qb = Qs + (g * 128 + 64 * qh + 32 * sub + q) * QS_STRIDE + 16 * h;
#pragma unroll
        for (int s4 = 0; s4 < 4; ++s4) Qf2[sub][s4] = *(const LAS bf16x8*)(qb + 32 * s4);
    }
    LAS unsigned char* ost = Qs + (g * 128 + 64 * qh) * QS_STRIDE;
    constexpr int OS_STRIDE = 272;
#pragma unroll
    for (int sub = 0; sub < 2; ++sub) {
        const int i0 = 64 * qh + 32 * sub, kt0 = 2 * qh + sub;
        const size_t row0 = (size_t)b * SEQ + n * 128 + i0;
        u32x4 graw[4];
#pragma unroll
        for (int i = 0; i < 4; ++i) graw[i] = __builtin_nontemporal_load((const u32x4*)(proj + (row0 + 8 * i + (lane >> 3)) * INW + OFF_GA + head * 64 + 8 * (lane & 7)));
        const bf16x8* Qf = Qf2[sub];
        f32x16 S[5];
#pragma unroll
        for (int t = 0; t < 5; ++t) {
#pragma unroll
            for (int r = 0; r < 16; ++r) S[t][r] = 0.f;
            const LAS unsigned char* kb = Ks + (32 * (kt0 + t) + q) * KS_STRIDE + 16 * h;
#pragma unroll
            for (int s = 0; s < 4; ++s) { const bf16x8 kf = *(const LAS bf16x8*)(kb + 32 * s);
                S[t] = __builtin_amdgcn_mfma_f32_32x32x16_bf16(kf, Qf[s], S[t], 0, 0, 0); }
        }
        float m = sink2;
#pragma unroll
        for (int t = 0; t < 5; ++t) {
            const bool tile_ok = (n > 0) || (kt0 + t >= 4);
#pragma unroll
            for (int r = 0; r < 16; ++r) {
                const int keyrow = (r & 3) + 8 * (r >> 2) + 4 * h;
                bool valid = tile_ok;
                if (t == 0) valid = valid && (keyrow > q);
                if (t == 4) valid = valid && (keyrow <= q);
                const float sv = valid ? S[t][r] : -1e30f;
                S[t][r] = sv; m = fmaxf(m, sv);
            }
        }
        m = fmaxf(m, __shfl_xor(m, 32));
        float l = 0.f;
#pragma unroll
        for (int t = 0; t < 5; ++t)
#pragma unroll
            for (int r = 0; r < 16; ++r) { const float pv = __builtin_amdgcn_exp2f(S[t][r] - m); S[t][r] = pv; l += pv; }
        l += __shfl_xor(l, 32);
        const float inv = __builtin_amdgcn_rcpf(l + __builtin_amdgcn_exp2f(sink2 - m));
        f32x16 O[2];
#pragma unroll
        for (int dt = 0; dt < 2; ++dt)
#pragma unroll
            for (int r = 0; r < 16; ++r) O[dt][r] = 0.f;
#pragma unroll
        for (int t = 0; t < 5; ++t)
#pragma unroll
            for (int s2 = 0; s2 < 2; ++s2) {
                u32x4 w; w.x = pk(S[t][8 * s2 + 0], S[t][8 * s2 + 1]); w.y = pk(S[t][8 * s2 + 2], S[t][8 * s2 + 3]); w.z = pk(S[t][8 * s2 + 4], S[t][8 * s2 + 5]); w.w = pk(S[t][8 * s2 + 6], S[t][8 * s2 + 7]);
                const bf16x8 pb = __builtin_bit_cast(bf16x8, w);
#pragma unroll
                for (int dt = 0; dt < 2; ++dt) {
                    const LAS unsigned char* vb = Vt + (32 * dt + q) * VT_STRIDE + 2 * (32 * (kt0 + t) + 16 * s2 + 4 * h);
                    const u32x2 v0 = *(const LAS u32x2*)(vb), v1 = *(const LAS u32x2*)(vb + 16);
                    u32x4 vv; vv.x = v0.x; vv.y = v0.y; vv.z = v1.x; vv.w = v1.y;
                    O[dt] = __builtin_amdgcn_mfma_f32_32x32x16_bf16(__builtin_bit_cast(bf16x8, vv), pb, O[dt], 0, 0, 0);
                }
            }
#pragma unroll
        for (int dt = 0; dt < 2; ++dt)
#pragma unroll
            for (int g4 = 0; g4 < 4; ++g4) { f32x4 ov = {O[dt][4 * g4 + 0] * inv, O[dt][4 * g4 + 1] * inv, O[dt][4 * g4 + 2] * inv, O[dt][4 * g4 + 3] * inv};
                *(LAS f32x4*)(ost + q * OS_STRIDE + (32 * dt + 8 * g4 + 4 * h) * 4) = ov; }
#pragma unroll
        for (int i = 0; i < 4; ++i) {
            const int r = 8 * i + (lane >> 3), c = lane & 7;
            const f32x4 a0 = *(const LAS f32x4*)(ost + r * OS_STRIDE + c * 32), a1 = *(const LAS f32x4*)(ost + r * OS_STRIDE + c * 32 + 16);
            const u32x4 gw = graw[i];
            u32x4 w; w.x = pk(a0.x * bflo(gw.x), a0.y * bfhi(gw.x)); w.y = pk(a0.z * bflo(gw.y), a0.w * bfhi(gw.y));
            w.z = pk(a1.x * bflo(gw.z), a1.y * bfhi(gw.z)); w.w = pk(a1.z * bflo(gw.w), a1.w * bfhi(gw.w));
            __builtin_nontemporal_store(w, (u32x4*)(Y + (row0 + r) * DM + head * 64 + 8 * c));
        }
        asm volatile("" ::: "memory");
    }
    __syncthreads();
}

constexpr int CO_OFF = 94 * 1024;
__device__ __forceinline__ void conv_unit(const Params& p, LAS unsigned char* lds, int unit, int tid, int wave, int lane) {
    const bf16_t* proj = (const bf16_t*)(p.ws + WS_PROJ);
    bf16_t* Y = (bf16_t*)(p.ws + WS_Y);
    const int b = unit >> 5, T0 = (unit & 31) * 64;
    const size_t rowbase = (size_t)b * SEQ;
    const int cp = tid & 255, sh = tid >> 8;
    {
        const bf16_t* Zb = (const bf16_t*)(p.ws + WS_Z);
        u32x4 zv[12];
#pragma unroll
        for (int i = 0; i < 12; ++i) {
            const int ch = tid + 512 * i, rel = min(ch >> 6, 93), c8 = ch & 63, pos = max(T0 - 30 + rel, 0);
            zv[i] = *(const u32x4*)(Zb + (rowbase + pos) * 512 + 8 * c8);
        }
#pragma unroll
        for (int i = 0; i < 12; ++i) {
            const int ch = tid + 512 * i, rel = ch >> 6, c8 = ch & 63;
            const u32x4 zero = {0u, 0u, 0u, 0u};
            if (rel < 94) *(LAS u32x4*)(lds + rel * 1024 + 16 * c8) = (T0 - 30 + rel) >= 0 ? zv[i] : zero;
        }
    }
    asm volatile("" ::: "memory");
    f32x2 wv[31];
#pragma unroll
    for (int j = 0; j < 31; ++j) wv[j] = *(const f32x2*)(p.conv_w + j * 512 + 2 * cp);
    const f32x2 bz = *(const f32x2*)(p.conv_b + 2 * cp);
    __syncthreads();
#pragma unroll 1
    for (int hh = 0; hh < 2; ++hh) {
        u32x4 gb[4];
#pragma unroll
        for (int r = 0; r < 4; ++r) gb[r] = *(const u32x4*)(proj + (rowbase + T0 + 32 * hh + wave * 4 + r) * INW + OFF_GB + 8 * lane);
        {
            f32x2 ac[16];
#pragma unroll
            for (int t = 0; t < 16; ++t) ac[t] = bz;
            const LAS unsigned char* zb = lds + (32 * hh + 16 * sh) * 1024 + 4 * cp;
#pragma unroll
            for (int r = 0; r < 46; ++r) {
                if ((r & 7) == 0) asm volatile("" ::: "memory");
                const unsigned zz = *(const LAS unsigned*)(zb + r * 1024);
                const f32x2 z2 = {bflo(zz), bfhi(zz)};
#pragma unroll
                for (int t = 0; t < 16; ++t) { const int j = r - t; if (j >= 0 && j <= 30) ac[t] = __builtin_elementwise_fma(wv[j], z2, ac[t]); }
            }
            if (hh) __syncthreads();
            LAS unsigned char* cb = lds + CO_OFF + (16 * sh) * 2048 + 8 * cp;
#pragma unroll
            for (int t = 0; t < 16; ++t) *(LAS f32x2*)(cb + t * 2048) = ac[t];
        }
        __syncthreads();
        const f32x4 lw0 = *(const f32x4*)(p.ln_w + 8 * lane), lw1 = *(const f32x4*)(p.ln_w + 8 * lane + 4);
        const f32x4 lb0 = *(const f32x4*)(p.ln_b + 8 * lane), lb1 = *(const f32x4*)(p.ln_b + 8 * lane + 4);
#pragma unroll
        for (int r = 0; r < 4; ++r) {
            const int tl = wave * 4 + r; const size_t row = rowbase + T0 + 32 * hh + tl;
            f32x4 v0 = *(const LAS f32x4*)(lds + CO_OFF + tl * 2048 + 32 * lane), v1 = *(const LAS f32x4*)(lds + CO_OFF + tl * 2048 + 32 * lane + 16);
            float s1 = (v0.x + v0.y) + (v0.z + v0.w) + (v1.x + v1.y) + (v1.z + v1.w);
            float s2 = (v0.x * v0.x + v0.y * v0.y) + (v0.z * v0.z + v0.w * v0.w) + (v1.x * v1.x + v1.y * v1.y) + (v1.z * v1.z + v1.w * v1.w);
            s1 = wave_sum(s1); s2 = wave_sum(s2);
            const float mean = s1 * (1.0f / 512.0f), var = fmaxf(s2 * (1.0f / 512.0f) - mean * mean, 0.f);
            const float rstd = rsqrtf(var + EPS);
            v0 = v0 - mean; v1 = v1 - mean;
            v0 = v0 * rstd * lw0 + lb0; v1 = v1 * rstd * lw1 + lb1;
            u32x4 o;
            o.x = pk(silu_f(v0.x) * bflo(gb[r].x), silu_f(v0.y) * bfhi(gb[r].x));
            o.y = pk(silu_f(v0.z) * bflo(gb[r].y), silu_f(v0.w) * bfhi(gb[r].y));
            o.z = pk(silu_f(v1.x) * bflo(gb[r].z), silu_f(v1.y) * bfhi(gb[r].z));
            o.w = pk(silu_f(v1.z) * bflo(gb[r].w), silu_f(v1.w) * bfhi(gb[r].w));
            __builtin_nontemporal_store(o, (u32x4*)(Y + row * DM + 512 + 8 * lane));
        }
    }
    __syncthreads();
}

__device__ __forceinline__ Params load_params() {
#if defined(__HIP_DEVICE_COMPILE__)
    const __attribute__((address_space(4))) Params* kp = (const __attribute__((address_space(4))) Params*)__builtin_amdgcn_kernarg_segment_ptr();
    asm volatile("" : "+s"(kp));
    return *kp;
#else
    return Params{};
#endif
}
__global__ void __launch_bounds__(512, 2) fwd_kernel(Params p) {
    extern __shared__ __attribute__((aligned(16))) unsigned char lds_raw[];
    LAS unsigned char* lds = (LAS unsigned char*)lds_raw;
    const int tid = threadIdx.x, lane = tid & 63, wave = __builtin_amdgcn_readfirstlane(tid >> 6);
    if (tid < 64) ((LAS unsigned*)(lds + MISC_OFF))[tid] = 0u;
    float nwv = 0.f;
    if (tid >= 128 && tid < 256) nwv = (tid < 192) ? p.q_norm_w[tid - 128] : p.k_norm_w[tid - 192];
    __syncthreads();
    XcdBarrier bar = xcd_barrier_post((unsigned*)(p.ws + WS_CTL), (volatile LAS unsigned*)(lds + MISC_OFF) + 8);
    if (p.never) cg::this_grid().sync();

    { const Params q = load_params(); phase01(q, lds, tid, wave, lane); }
    if (tid >= 128 && tid < 256) ((LAS float*)(lds + NW_OFF))[tid - 128] = nwv;
    xcd_barrier(bar);
    {
        const Params q = load_params();
        pg8::Gemm g{(const bf16_t*)(q.ws + WS_H), (const bf16_t*)(q.ws + WS_WINT), MTOK, INW, DM};
        pg8::StaticOrder S; S.init(MTOK, INW, (int)gridDim.x, (int)blockIdx.x);
        pg8::EpiProj E{(bf16_t*)(q.ws + WS_PROJ), INW, (bf16_t*)(q.ws + WS_Z)};
        pg8::gemm_phase<pg8::EpiProj, pg8::StaticOrder, GEMM_ALIGN, GEMM_SP2>(lds, g, S, E);
    }
    xcd_barrier(bar);
    for (int u = blockIdx.x; u < 256; u += gridDim.x) { const Params q = load_params(); attn_unit(q, lds, u, tid, wave, lane); }
    for (int u = blockIdx.x; u < 256; u += gridDim.x) { const Params q = load_params(); conv_unit(q, lds, u, tid, wave, lane); }
    xcd_barrier(bar);
    {
        const Params q = load_params();
        pg8::Gemm g{(const bf16_t*)(q.ws + WS_Y), (const bf16_t*)(q.ws + WS_WOUTT), MTOK, DM, DM};
        pg8::StaticOrder S; S.init(MTOK, DM, (int)gridDim.x, (int)blockIdx.x);
        pg8::EpiOut E{q.x, q.out, (const float*)(q.ws + WS_MOD)};
        pg8::gemm_phase<pg8::EpiOut, pg8::StaticOrder, false, GEMM_SP2>(lds, g, S, E);
    }
}

extern "C" void kernel_launch(void* const* d_in, const int* in_sizes, int n_in, void* d_out, int out_size, void* d_ws, size_t ws_size, hipStream_t stream) {
    static int grid = 0;
    if (grid == 0) {
        if (n_in != 14 || out_size != MTOK * DM || ws_size < WS_END) { fprintf(stderr, "kernel_launch: unexpected shapes (n_in %d, out %d, ws %zu)\n", n_in, out_size, ws_size); grid = -1; return; }
        int dev = 0, cus = 0, per_cu = 0;
        (void)hipGetDevice(&dev);
        (void)hipDeviceGetAttribute(&cus, hipDeviceAttributeMultiprocessorCount, dev);
        if (hipFuncSetAttribute((const void*)fwd_kernel, hipFuncAttributeMaxDynamicSharedMemorySize, LDS_BYTES) != hipSuccess) { fprintf(stderr, "kernel_launch: hipFuncSetAttribute failed\n"); grid = -1; return; }
        if (hipOccupancyMaxActiveBlocksPerMultiprocessor(&per_cu, (const void*)fwd_kernel, 512, LDS_BYTES) != hipSuccess || per_cu < 1) { fprintf(stderr, "kernel_launch: occupancy query says %d\n", per_cu); per_cu = 1; }
        (void)hipGetLastError();
        grid = cus > 0 ? cus : 256;
        if (grid > 256) grid = 256;
    }
    if (grid < 0) return;
    (void)hipMemsetAsync((char*)d_ws + WS_CTL, 0, CTL_BYTES, stream);
    Params p{};
    const float** pp = (const float**)&p;
    for (int i = 0; i < 14; ++i) pp[i] = (const float*)d_in[i];
    p.out = (float*)d_out; p.ws = (unsigned char*)d_ws; p.never = 0; p.pad = 0;
    void* args[] = {&p};
    const hipError_t e = hipLaunchCooperativeKernel((const void*)fwd_kernel, dim3(grid), dim3(512), args, LDS_BYTES, stream);
    if (e != hipSuccess) fprintf(stderr, "kernel_launch: cooperative launch failed: %s (grid %d)\n", hipGetErrorString(e), grid);
}
```

```cpp
#include <hip/hip_runtime.h>
#include <hip/hip_cooperative_groups.h>
#include <cstdio>
namespace cg = cooperative_groups;
#define GEMM_ALIGN true
#define GEMM_SP2 true
namespace pg8 {
#define PG8_LAS __attribute__((address_space(3)))
typedef unsigned short bf16_t;
typedef short bf16x8 __attribute__((ext_vector_type(8)));
typedef float f32x4 __attribute__((ext_vector_type(4)));
typedef unsigned u32x4 __attribute__((ext_vector_type(4)));
constexpr int BM = 256, BK = 64, HALF = 128, HTB = HALF * BK * 2  , STAGE_BYTES = 8 * HTB, NXCD = 8, WGM = 8;

__host__ __device__ __forceinline__ int lds_byte(int r, int c) { const int st = (r >> 4) * 2 + (c >> 5), rr = r & 15, cc = c & 31, ob = rr * 64 + cc * 2; return st * 1024 + (ob ^ (((ob >> 9) & 1) << 5)); }
__host__ __device__ __forceinline__ void stage_rc(int b, int& R, int& C) { const int st = b / 1024, sb = b % 1024, swz = sb ^ (((sb >> 9) & 1) << 5); R = (st >> 1) * 16 + swz / 64; C = (st & 1) * 32 + (swz % 64) / 2; }
__host__ __device__ __forceinline__ int perm32(int rho) { const int n = rho >> 4, i = rho & 15; return 8 * (i >> 2) + 4 * n + (i & 3); }

struct Unit { int pm, pn; };
struct Gemm { const bf16_t* A; const bf16_t* Bt; int M, N, K; };

struct StaticOrder {
    int nM, nN, nwg, G, c;
    __host__ __device__ void init(int M, int N, int G_, int c_) { nM = M / BM; nN = N / BM; nwg = nM * nN; G = G_; c = c_; }
    __host__ __device__ bool next(int i, Unit& u) const {
        const long L = (long)i * G + c; if (L >= nwg) return false;
        int wgid = (int)L; { const int q = nwg / NXCD, r = nwg % NXCD, xcd = wgid % NXCD, off = wgid / NXCD; wgid = (xcd < r ? xcd * (q + 1) : r * (q + 1) + (xcd - r) * q) + off; }
        const int nig = WGM * nN, gid = wgid / nig, fm = gid * WGM, gsz = (nM - fm) < WGM ? (nM - fm) : WGM;
        u.pm = fm + ((wgid % nig) % gsz); u.pn = (wgid % nig) / gsz; return true;
    }
    __device__ __forceinline__ void a_ready(const Unit&) const {}
    __device__ __forceinline__ void done(const Unit&) const {}
};
__device__ __forceinline__ unsigned cvt_pk_bf16(float lo, float hi) { unsigned r; asm volatile("v_cvt_pk_bf16_f32 %0, %1, %2" : "=v"(r) : "v"(lo), "v"(hi)); return r; }
template <class Epi, class Sched, bool ALIGN_EPI = false, bool SP2 = false>
__device__ __forceinline__ void gemm_phase(PG8_LAS unsigned char* lds, const Gemm g, const Sched& S, const Epi& E) {
    const int tid = threadIdx.x, wid = __builtin_amdgcn_readfirstlane(tid >> 6), lane = tid & 63, wr = wid >> 2, wc = wid & 3, fr = lane & 15, fq = lane >> 4;
    const int K = g.K, nt = K / BK;
    unsigned voffA[2], voffB[2];
#pragma unroll
    for (int i = 0; i < 2; ++i) { int R, C; stage_rc(tid * 16 + i * 8192, R, C); const int Rb = Epi::PERM ? ((R & ~31) + perm32(R & 31)) : R;
        voffA[i] = (unsigned)(R * K + C) * 2u; voffB[i] = (unsigned)(Rb * K + C) * 2u; }
    const size_t kstep = (size_t)(BK * 2);
    const size_t hstep = (size_t)HALF * K * 2;
    const size_t tstep = 2 * hstep;
    const unsigned ldsw = (unsigned)wid * 1024u;
    const int aoff = lds_byte(wr * 64 + fr, fq * 8), boff = lds_byte(wc * 32 + fr, fq * 8);
#define PG8_SA(b, h) (((b) * 2 + (h)) * HTB)
#define PG8_SB(b, h) ((4 + (b) * 2 + (h)) * HTB)
#define PG8_STAGE(bufoff, gbase, voff) do { _Pragma("unroll") for (int _i = 0; _i < 2; ++_i) \
        __builtin_amdgcn_global_load_lds((const unsigned*)((const char*)(gbase) + (voff)[_i]), (PG8_LAS unsigned*)(lds + (bufoff) + ldsw + _i * 8192), 16, 0, 0); } while (0)
#define PG8_LDA(dst, b, h) do { _Pragma("unroll") for (int m = 0; m < 4; ++m) _Pragma("unroll") for (int k = 0; k < 2; ++k) dst[m][k] = *(const PG8_LAS bf16x8*)(lds + PG8_SA(b, h) + aoff + m * 2048 + k * 1024); } while (0)
#define PG8_LDB(dst, b, h) do { _Pragma("unroll") for (int n = 0; n < 2; ++n) _Pragma("unroll") for (int k = 0; k < 2; ++k) dst[n][k] = *(const PG8_LAS bf16x8*)(lds + PG8_SB(b, h) + boff + n * 2048 + k * 1024); } while (0)
#define PG8_MMA(ai, bj, At, Bt) do { __builtin_amdgcn_s_setprio(1); _Pragma("unroll") for (int m = 0; m < 4; ++m) _Pragma("unroll") for (int n = 0; n < 2; ++n) _Pragma("unroll") for (int k = 0; k < 2; ++k) \
        acc[ai][bj][m][n] = __builtin_amdgcn_mfma_f32_16x16x32_bf16(Bt[n][k], At[m][k], acc[ai][bj][m][n], 0, 0, 0); __builtin_amdgcn_s_setprio(0); } while (0)
#define PG8_WAIT_V(n) asm volatile("s_waitcnt vmcnt(" #n ")" ::: "memory")
#define PG8_WAIT_L(n) asm volatile("s_waitcnt lgkmcnt(" #n ")" ::: "memory")
#define PG8_BAR __builtin_amdgcn_s_barrier()
#define PG8_SCHED __builtin_amdgcn_sched_barrier(0)
    Unit cur, nxt; int ui = 0;
    if (!S.next(0, cur)) return;
    f32x4 acc[2][2][4][2];
#pragma unroll
    for (int a = 0; a < 2; ++a)
#pragma unroll
        for (int b = 0; b < 2; ++b)
#pragma unroll
            for (int m = 0; m < 4; ++m)
#pragma unroll
                for (int n = 0; n < 2; ++n) acc[a][b][m][n] = (f32x4){0.f, 0.f, 0.f, 0.f};
    bf16x8 At[4][2], B0[2][2], B1[2][2];
    const char* cA = (const char*)g.A + (size_t)cur.pm * tstep; const char* cB = (const char*)g.Bt + (size_t)cur.pn * tstep;
    S.a_ready(cur);
    if constexpr (SP2) {
        PG8_STAGE(PG8_SB(0, 0), cB, voffB); PG8_STAGE(PG8_SB(0, 1), cB + hstep, voffB); PG8_STAGE(PG8_SA(0, 0), cA, voffA); PG8_STAGE(PG8_SA(0, 1), cA + hstep, voffA);
        if (wr == 1) PG8_BAR;
        PG8_WAIT_V(2); PG8_BAR;
        PG8_STAGE(PG8_SB(1, 0), cB + kstep, voffB); PG8_STAGE(PG8_SA(1, 0), cA + kstep, voffA); PG8_STAGE(PG8_SB(1, 1), cB + hstep + kstep, voffB);
        PG8_WAIT_V(6); PG8_BAR;
    } else {
        PG8_STAGE(PG8_SB(0, 0), cB, voffB); PG8_STAGE(PG8_SA(0, 0), cA, voffA); PG8_STAGE(PG8_SB(0, 1), cB + hstep, voffB); PG8_STAGE(PG8_SA(0, 1), cA + hstep, voffA);
        if (wr == 1) PG8_BAR;
        PG8_WAIT_V(4); PG8_BAR;
        PG8_STAGE(PG8_SB(1, 0), cB + kstep, voffB); PG8_STAGE(PG8_SA(1, 0), cA + kstep, voffA); PG8_STAGE(PG8_SB(1, 1), cB + hstep + kstep, voffB);
        PG8_WAIT_V(6); PG8_BAR;
    }
    for (;;) {
        const bool has_next = S.next(ui + 1, nxt);
        const char* nA = has_next ? (const char*)g.A + (size_t)nxt.pm * tstep : cA; const char* nB = has_next ? (const char*)g.Bt + (size_t)nxt.pn * tstep : cB;
        for (int t = 0; t < nt; t += 2) {
            const bool last = (t == nt - 2);
            const char* a1 = cA + (size_t)(t + 1) * kstep;
            const char* a2 = last ? nA : cA + (size_t)(t + 2) * kstep; const char* b2 = last ? nB : cB + (size_t)(t + 2) * kstep;
            const char* a3 = a2 + kstep; const char* b3 = b2 + kstep;
            if (last && has_next) S.a_ready(nxt);
            if constexpr (SP2) {
            PG8_LDB(B0, 0, 0); PG8_LDB(B1, 0, 1); PG8_SCHED; PG8_LDA(At, 0, 0); PG8_STAGE(PG8_SA(1, 1), a1 + hstep, voffA);
            PG8_WAIT_V(8); PG8_WAIT_L(0); PG8_BAR; PG8_MMA(0, 0, At, B0); PG8_MMA(0, 1, At, B1); PG8_BAR; PG8_SCHED;
            PG8_LDA(At, 0, 1); PG8_STAGE(PG8_SB(0, 0), b2, voffB); PG8_STAGE(PG8_SB(0, 1), b2 + hstep, voffB); PG8_STAGE(PG8_SA(0, 0), a2, voffA);
            PG8_WAIT_V(8); PG8_WAIT_L(0); PG8_BAR; PG8_MMA(1, 0, At, B0); PG8_MMA(1, 1, At, B1); PG8_BAR; PG8_SCHED;
            PG8_LDB(B0, 1, 0); PG8_LDB(B1, 1, 1); PG8_SCHED; PG8_LDA(At, 1, 0); PG8_STAGE(PG8_SA(0, 1), a2 + hstep, voffA);
            PG8_WAIT_V(8); PG8_WAIT_L(0); PG8_BAR; PG8_MMA(0, 0, At, B0); PG8_MMA(0, 1, At, B1); PG8_BAR; PG8_SCHED;
            PG8_LDA(At, 1, 1); PG8_STAGE(PG8_SB(1, 0), b3, voffB); PG8_STAGE(PG8_SB(1, 1), b3 + hstep, voffB); PG8_STAGE(PG8_SA(1, 0), a3, voffA);
            PG8_WAIT_V(8); PG8_WAIT_L(0); PG8_BAR; PG8_MMA(1, 0, At, B0); PG8_MMA(1, 1, At, B1); PG8_BAR; PG8_SCHED;
            } else {
            PG8_LDB(B0, 0, 0); PG8_SCHED; PG8_LDA(At, 0, 0); PG8_STAGE(PG8_SA(1, 1), a1 + hstep, voffA);
            PG8_WAIT_L(8); PG8_BAR; PG8_WAIT_L(0); PG8_MMA(0, 0, At, B0); PG8_BAR; PG8_SCHED;
            PG8_LDB(B1, 0, 1); PG8_STAGE(PG8_SB(0, 0), b2, voffB);
            PG8_BAR; PG8_WAIT_L(0); PG8_MMA(0, 1, At, B1); PG8_BAR;
            PG8_LDA(At, 0, 1); PG8_STAGE(PG8_SA(0, 0), a2, voffA);
            PG8_BAR; PG8_WAIT_L(0); PG8_MMA(1, 0, At, B0); PG8_BAR; PG8_SCHED;
            PG8_STAGE(PG8_SB(0, 1), b2 + hstep, voffB);
            PG8_WAIT_V(6); PG8_BAR; PG8_MMA(1, 1, At, B1); PG8_BAR;
            PG8_LDB(B0, 1, 0); PG8_SCHED; PG8_LDA(At, 1, 0); PG8_STAGE(PG8_SA(0, 1), a2 + hstep, voffA);
            PG8_WAIT_L(8); PG8_BAR; PG8_WAIT_L(0); PG8_MMA(0, 0, At, B0); PG8_BAR; PG8_SCHED;
            PG8_LDB(B1, 1, 1); PG8_STAGE(PG8_SB(1, 0), b3, voffB);
            PG8_BAR; PG8_WAIT_L(0); PG8_MMA(0, 1, At, B1); PG8_BAR;
            PG8_LDA(At, 1, 1); PG8_STAGE(PG8_SA(1, 0), a3, voffA);
            PG8_BAR; PG8_WAIT_L(0); PG8_MMA(1, 0, At, B0); PG8_BAR; PG8_SCHED;
            PG8_STAGE(PG8_SB(1, 1), b3 + hstep, voffB);
            PG8_WAIT_V(6); PG8_BAR; PG8_MMA(1, 1, At, B1); PG8_BAR;
            }
        }
        if constexpr (ALIGN_EPI) { if (wr == 0) PG8_BAR; }
        if constexpr (!Epi::AFTER_DRAIN) { E(acc, cur, wr, wc, fr, fq); S.done(cur); }
        if (!has_next) break;
#pragma unroll
        for (int a = 0; a < 2; ++a)
#pragma unroll
            for (int b = 0; b < 2; ++b)
#pragma unroll
                for (int m = 0; m < 4; ++m)
#pragma unroll
                    for (int n = 0; n < 2; ++n) acc[a][b][m][n] = (f32x4){0.f, 0.f, 0.f, 0.f};
        cur = nxt; cA = nA; cB = nB; ++ui;
        if constexpr (ALIGN_EPI) { if (wr == 1) PG8_BAR; }
    }
    PG8_WAIT_V(0);
    if constexpr (!ALIGN_EPI) { if (wr == 0) PG8_BAR; }
    PG8_BAR;
    if constexpr (Epi::AFTER_DRAIN) { E.fused(acc, cur, wr, wc, fr, fq, lds, wid, lane); S.done(cur); }
#undef PG8_SA
#undef PG8_SB
#undef PG8_STAGE
#undef PG8_LDA
#undef PG8_LDB
#undef PG8_MMA
#undef PG8_WAIT_V
#undef PG8_WAIT_L
#undef PG8_BAR
#undef PG8_SCHED
}
}
namespace pg8 {
struct EpiProj {
    static constexpr bool PERM = true, AFTER_DRAIN = false;
    bf16_t* O; int ldc; bf16_t* Z;
    __device__ __forceinline__ void operator()(const f32x4 (&acc)[2][2][4][2], const Unit& u, int wr, int wc, int fr, int fq) const {
        const int row0 = u.pm * BM + wr * 64 + fr;
        if (u.pn >= 5 && u.pn < 9) {
            const int zc = (u.pn - 5) * 128 + wc * 32 + 8 * fq;
#pragma unroll
            for (int ai = 0; ai < 2; ++ai)
#pragma unroll
                for (int m = 0; m < 4; ++m) { bf16_t* zp = Z + (size_t)(row0 + ai * HALF + m * 16) * 512 + zc;
                    const f32x4 a0 = acc[ai][0][m][0], a1 = acc[ai][0][m][1], g0 = acc[ai][1][m][0], g1 = acc[ai][1][m][1];
                    f32x4 z0, z1;
#pragma unroll
                    for (int e = 0; e < 4; ++e) { z0[e] = a0[e] * __builtin_amdgcn_rcpf(1.0f + __builtin_amdgcn_exp2f(g0[e] * -1.4426950408889634f));
                                                  z1[e] = a1[e] * __builtin_amdgcn_rcpf(1.0f + __builtin_amdgcn_exp2f(g1[e] * -1.4426950408889634f)); }
                    u32x4 w; w.x = cvt_pk_bf16(z0[0], z0[1]); w.y = cvt_pk_bf16(z0[2], z0[3]); w.z = cvt_pk_bf16(z1[0], z1[1]); w.w = cvt_pk_bf16(z1[2], z1[3]);
                    *(u32x4*)zp = w; }
            return;
        }
        const int col0 = u.pn * BM + wc * 32 + 8 * fq;
        const bool gate_tile = (u.pn == 3) || (u.pn == 4) || (u.pn >= 9);
#pragma unroll
        for (int ai = 0; ai < 2; ++ai)
#pragma unroll
            for (int m = 0; m < 4; ++m) { bf16_t* rowp = O + (size_t)(row0 + ai * HALF + m * 16) * ldc + col0;
#pragma unroll
                for (int bj = 0; bj < 2; ++bj) { f32x4 v0 = acc[ai][bj][m][0], v1 = acc[ai][bj][m][1];
                    if (gate_tile) {
#pragma unroll
                        for (int e = 0; e < 4; ++e) { v0[e] = v0[e] * __builtin_amdgcn_rcpf(1.0f + __builtin_amdgcn_exp2f(v0[e] * -1.4426950408889634f));
                                                      v1[e] = v1[e] * __builtin_amdgcn_rcpf(1.0f + __builtin_amdgcn_exp2f(v1[e] * -1.4426950408889634f)); } }
                    u32x4 w; w.x = cvt_pk_bf16(v0[0], v0[1]); w.y = cvt_pk_bf16(v0[2], v0[3]); w.z = cvt_pk_bf16(v1[0], v1[1]); w.w = cvt_pk_bf16(v1[2], v1[3]);
                    *(u32x4*)(rowp + bj * HALF) = w; } }
    }
};
struct EpiOut {
    static constexpr bool PERM = false, AFTER_DRAIN = false;
    const float* X; float* C; const float* mod;
    __device__ __forceinline__ void operator()(const f32x4 (&acc)[2][2][4][2], const Unit& u, int wr, int wc, int fr, int fq) const {
        const int row0 = u.pm * BM + wr * 64 + fr, col0 = u.pn * BM + wc * 32 + 4 * fq;
        const float* gp = mod + (size_t)(u.pm >> 3) * 3072 + 2048 + col0;
        const float* xb = X + (size_t)row0 * 1024 + col0; float* cb = C + (size_t)row0 * 1024 + col0;
        f32x4 gv[2][2];
#pragma unroll
        for (int bj = 0; bj < 2; ++bj)
#pragma unroll
            for (int n = 0; n < 2; ++n) gv[bj][n] = *(const f32x4*)(gp + bj * HALF + n * 16);
        constexpr int DEPTH = 4;
        f32x4 xs[DEPTH][2][2];
#pragma unroll
        for (int gi = 0; gi < DEPTH; ++gi) { const size_t off = (size_t)((gi >> 2) * HALF + (gi & 3) * 16) * 1024;
#pragma unroll
            for (int bj = 0; bj < 2; ++bj)
#pragma unroll
                for (int n = 0; n < 2; ++n) xs[gi][bj][n] = __builtin_nontemporal_load((const f32x4*)(xb + off + bj * HALF + n * 16)); }
#pragma unroll
        for (int gi = 0; gi < 8; ++gi) { const int ai = gi >> 2, m = gi & 3; const size_t off = (size_t)(ai * HALF + m * 16) * 1024;
#pragma unroll
            for (int bj = 0; bj < 2; ++bj)
#pragma unroll
                for (int n = 0; n < 2; ++n) __builtin_nontemporal_store(xs[gi % DEPTH][bj][n] + gv[bj][n] * acc[ai][bj][m][n], (f32x4*)(cb + off + bj * HALF + n * 16));
            if (gi + DEPTH < 8) { const int g2 = gi + DEPTH; const size_t off2 = (size_t)((g2 >> 2) * HALF + (g2 & 3) * 16) * 1024;
#pragma unroll
                for (int bj = 0; bj < 2; ++bj)
#pragma unroll
                    for (int n = 0; n < 2; ++n) xs[gi % DEPTH][bj][n] = __builtin_nontemporal_load((const f32x4*)(xb + off2 + bj * HALF + n * 16)); }
        }
    }
};
}
#define LAS __attribute__((address_space(3)))
typedef unsigned short bf16_t;
typedef float f32x2 __attribute__((ext_vector_type(2)));
typedef float f32x4 __attribute__((ext_vector_type(4)));
typedef float f32x16 __attribute__((ext_vector_type(16)));
typedef short bf16x8 __attribute__((ext_vector_type(8)));
typedef short s16x4 __attribute__((ext_vector_type(4)));
typedef unsigned u32x2 __attribute__((ext_vector_type(2)));
typedef unsigned u32x4 __attribute__((ext_vector_type(4)));
typedef __bf16 bf16x2_t __attribute__((ext_vector_type(2)));

constexpr int DM = 1024, NBATCH = 8, SEQ = 2048, MTOK = NBATCH * SEQ, INW = 2816;
constexpr int OFF_Q = 0, OFF_K = 512, OFF_V = 640, OFF_GA = 768, OFF_UA = 1280, OFF_UG = 1792, OFF_GB = 2304;
constexpr float EPS = 1e-6f;
constexpr size_t MiB = 1u << 20;
constexpr size_t WS_CTL = 0, CTL_BYTES = 16 * 1024;
constexpr size_t WS_MOD = 1 * MiB;
constexpr size_t WS_ROPE = 2 * MiB;
constexpr size_t WS_WINT = 4 * MiB;
constexpr size_t WS_WOUTT = 10 * MiB;
constexpr size_t WS_H = 16 * MiB;
constexpr size_t WS_PROJ = 48 * MiB;
constexpr size_t WS_Y = 144 * MiB;
constexpr size_t WS_Z = 176 * MiB;
constexpr size_t WS_END = 192 * MiB;
constexpr int RING_BYTES = 131072, LDS_BYTES = 163840, MISC_OFF = LDS_BYTES - 256, NW_OFF = 161792;

__device__ __forceinline__ float bflo(unsigned w) { return __uint_as_float(w << 16); }
__device__ __forceinline__ float bfhi(unsigned w) { return __uint_as_float(w & 0xffff0000u); }
__device__ __forceinline__ unsigned pk(float lo, float hi) { f32x2 v = {lo, hi}; bf16x2_t b = __builtin_convertvector(v, bf16x2_t); return __builtin_bit_cast(unsigned, b); }
template <int CTRL, int ROWMASK> __device__ __forceinline__ float dpp_f(float v) { return __builtin_bit_cast(float, __builtin_amdgcn_update_dpp(0, __builtin_bit_cast(int, v), CTRL, ROWMASK, 0xf, false)); }
__device__ __forceinline__ float wave_sum(float v) {
    v += dpp_f<0xB1, 0xf>(v);
    v += dpp_f<0x4E, 0xf>(v);
    v += dpp_f<0x141, 0xf>(v);
    v += dpp_f<0x140, 0xf>(v);
    v += dpp_f<0x142, 0xa>(v);
    v += dpp_f<0x143, 0xc>(v);
    return __builtin_bit_cast(float, __builtin_amdgcn_readlane(__builtin_bit_cast(int, v), 63));
}
__device__ __forceinline__ float sigm_f(float v) { return __builtin_amdgcn_rcpf(1.0f + __builtin_amdgcn_exp2f(v * -1.4426950408889634f)); }
__device__ __forceinline__ float silu_f(float v) { return v * sigm_f(v); }
#define LDS_WAIT() asm volatile("s_waitcnt lgkmcnt(0)" ::: "memory")

struct Params {
    const float *x, *c, *w_ada, *b_ada, *norm_w, *w_in, *q_norm_w, *k_norm_w, *sinks, *conv_w, *conv_b, *ln_w, *ln_b, *w_out;
    float* out; unsigned char* ws; int never; int pad;
};
#define XB_TMO      128
#define XB_XCNT(j)  (256  + 64 * (j))
#define XB_XSUB(j)  (1280 + 64 * (j))
#define XB_XGEN(j)  (2304 + 64 * (j))
#define XB_TOP      3328
#define XB_TOPGEN   3392
#define XCD_BAR_WORDS 3456
#define XB_SPIN_CAP (1u << 18)

__device__ __forceinline__ unsigned xb_ld(unsigned* p)              { return __hip_atomic_load(p, __ATOMIC_RELAXED, __HIP_MEMORY_SCOPE_AGENT); }
__device__ __forceinline__ unsigned xb_add(unsigned* p, unsigned v) { return __hip_atomic_fetch_add(p, v, __ATOMIC_RELAXED, __HIP_MEMORY_SCOPE_AGENT); }
__device__ __forceinline__ unsigned xb_xcc_id() { return (unsigned)__builtin_amdgcn_s_getreg((3 << 11) | 20) & 0xFu; }
#define XB_SPIN(cond, bar) do { unsigned _sp = 0; while (cond) { __builtin_amdgcn_s_sleep(1); \
    if ((++_sp & 255u) == 0u) { if (xb_ld(&(bar)[XB_TMO])) break; if (_sp > XB_SPIN_CAP) { atomicAdd(&(bar)[XB_TMO], 1u); break; } } } } while (0)

struct XcdBarrier {
    unsigned* bar; unsigned x;
    volatile LAS unsigned* st;
};

__device__ __forceinline__ XcdBarrier xcd_barrier_post(unsigned* bar, volatile LAS unsigned* st) {
    XcdBarrier b; b.bar = bar; b.x = xb_xcc_id(); b.st = st;
    if (threadIdx.x == 0) (void)xb_add(&bar[XB_XCNT(b.x)], 1u);
    return b;
}
__device__ __forceinline__ void xcd_barrier_complete(unsigned* bar, unsigned x, unsigned& nloc, unsigned& nx) {
    const unsigned G = gridDim.x * gridDim.y * gridDim.z;
    unsigned sum, cnt, mine, sp = 0u;
    for (;;) {
        sum = 0u; cnt = 0u; mine = 0u;
#pragma unroll
        for (unsigned j = 0; j < 16; ++j) { const unsigned c = xb_ld(&bar[XB_XCNT(j)]); sum += c; cnt += (c > 0u) ? 1u : 0u; mine = (j == x) ? c : mine; }
        if (sum == G) break;
        __builtin_amdgcn_s_sleep(1);
        if ((++sp & 255u) == 0u) { if (xb_ld(&bar[XB_TMO])) break; if (sp > XB_SPIN_CAP) { atomicAdd(&bar[XB_TMO], 1u); break; } }
    }
    nloc = mine > 0u ? mine : 1u; nx = cnt > 0u ? cnt : 1u;
}

__device__ __forceinline__ void xcd_barrier(const XcdBarrier& b) {
    asm volatile("s_waitcnt vmcnt(0)" ::: "memory");
    __syncthreads();
    if (threadIdx.x == 0) {
        unsigned* bar = b.bar;
        __builtin_amdgcn_s_waitcnt(0);
        unsigned nloc = b.st[0], nx = b.st[1];
        if (nloc == 0u) { xcd_barrier_complete(bar, b.x, nloc, nx); b.st[0] = nloc; b.st[1] = nx; }
        const unsigned old = xb_add(&bar[XB_XSUB(b.x)], 1u);
        const unsigned gen = old / nloc;
        if (old + 1u == (gen + 1u) * nloc) {
            __builtin_amdgcn_fence(__ATOMIC_RELEASE, "agent");
            asm volatile("s_waitcnt vmcnt(0)" ::: "memory");
            const unsigned og = xb_add(&bar[XB_TOP], 1u);
            const unsigned tg = og / nx;
            if (og + 1u == (tg + 1u) * nx) xb_add(&bar[XB_TOPGEN], 1u);
            else XB_SPIN(xb_ld(&bar[XB_TOPGEN]) == tg, bar);
            __builtin_amdgcn_fence(__ATOMIC_ACQUIRE, "agent");
            xb_add(&bar[XB_XGEN(b.x)], 1u);
            asm volatile("s_waitcnt vmcnt(0)" ::: "memory");
        } else {
            XB_SPIN(xb_ld(&bar[XB_XGEN(b.x)]) == gen, bar);
            __builtin_amdgcn_fence(__ATOMIC_ACQUIRE, "agent");
            asm volatile("s_waitcnt vmcnt(0)" ::: "memory");
        }
    }
    __syncthreads();
}
__device__ __forceinline__ int glu_col(int n0) {
    if (n0 >= OFF_UA && n0 < OFF_UG) { const int ch = n0 - OFF_UA; return OFF_UA + 256 * (ch >> 7) + (ch & 127); }
    if (n0 >= OFF_UG && n0 < OFF_GB) { const int ch = n0 - OFF_UG; return OFF_UA + 256 * (ch >> 7) + 128 + (ch & 127); }
    return n0;
}
__device__ __forceinline__ void p0_transpose_item(const float* W, int K, int N, bf16_t* WT, LAS float* scr, int item, int lane, bool remap) {
    const int nblk = N / 32, kb = item / nblk, nb = item % nblk, k0 = 64 * kb, n0 = 32 * nb, n0o = remap ? glu_col(n0) : n0;
    float tv[32];
#pragma unroll
    for (int i = 0; i < 32; ++i) tv[i] = __builtin_nontemporal_load(W + (size_t)(k0 + 2 * i + (lane >> 5)) * N + n0 + (lane & 31));
#pragma unroll
    for (int i = 0; i < 32; ++i) scr[(2 * i + (lane >> 5)) * 33 + (lane & 31)] = tv[i];
    LDS_WAIT(); asm volatile("" ::: "memory");
    const int c = lane & 7;
#pragma unroll
    for (int j = 0; j < 4; ++j) { const int n = (lane >> 3) + 8 * j; const LAS float* s = scr + (8 * c) * 33 + n;
        u32x4 o; o.x = pk(s[0 * 33], s[1 * 33]); o.y = pk(s[2 * 33], s[3 * 33]); o.z = pk(s[4 * 33], s[5 * 33]); o.w = pk(s[6 * 33], s[7 * 33]);
        *(u32x4*)(WT + (size_t)(n0o + n) * K + k0 + 8 * c) = o; }
    LDS_WAIT(); asm volatile("" ::: "memory");
}

constexpr int MODCNT_WORD = 3520;
constexpr int N_GEMV_ITEMS = 96;
__device__ __forceinline__ void p1_finish(const Params& p, const f32x4 (&v)[8][4], int rb, int wave, int lane) {
    const float* mod = (const float*)(p.ws + WS_MOD);
    bf16_t* H = (bf16_t*)(p.ws + WS_H);
    const int b = rb >> 5;
    f32x4 g[4], sh[4];
#pragma unroll
    for (int j = 0; j < 4; ++j) { const int k = 4 * lane + 256 * j;
        const f32x4 nw = *(const f32x4*)(p.norm_w + k), sc = *(const f32x4*)(mod + b * 3072 + 1024 + k);
        g[j] = nw * (sc + 1.0f); sh[j] = *(const f32x4*)(mod + b * 3072 + k); }
    const size_t row0 = (size_t)rb * 64 + wave * 8;
#pragma unroll
    for (int r = 0; r < 8; ++r) {
        float s = 0.f;
#pragma unroll
        for (int j = 0; j < 4; ++j) s += (v[r][j].x * v[r][j].x + v[r][j].y * v[r][j].y) + (v[r][j].z * v[r][j].z + v[r][j].w * v[r][j].w);
        const float rstd = rsqrtf(wave_sum(s) * (1.0f / DM) + EPS);
        u32x2* o8 = (u32x2*)(H + (row0 + r) * DM) + lane;
#pragma unroll
        for (int j = 0; j < 4; ++j) { const f32x4 hv = v[r][j] * rstd * g[j] + sh[j]; u32x2 w; w.x = pk(hv.x, hv.y); w.y = pk(hv.z, hv.w); __builtin_nontemporal_store(w, o8 + 64 * j); }
    }
}
__device__ __forceinline__ void p1_load(const Params& p, f32x4 (&v)[8][4], int rb, int wave, int lane) {
    const size_t row0 = (size_t)rb * 64 + wave * 8;
#pragma unroll
    for (int r = 0; r < 8; ++r) { const f32x4* xr = (const f32x4*)(p.x + (row0 + r) * DM) + lane;
#pragma unroll
        for (int j = 0; j < 4; ++j) v[r][j] = __builtin_nontemporal_load(xr + 64 * j); }
}
__device__ __forceinline__ void phase01(const Params& p, LAS unsigned char* lds, int tid, int wave, int lane) {
    float* mod = (float*)(p.ws + WS_MOD);
    unsigned* modcnt = (unsigned*)(p.ws + WS_CTL) + MODCNT_WORD;
    for (int item = blockIdx.x; item < N_GEMV_ITEMS; item += gridDim.x) {
        LAS float* cact = (LAS float*)lds;
        LAS float* red = (LAS float*)(lds + 32768);
        const int n0 = item * 32, kk = lane >> 3, c4 = lane & 7;
        float cv[16]; f32x4 wv[16];
#pragma unroll
        for (int i = 0; i < 16; ++i) cv[i] = p.c[tid + 512 * i];
#pragma unroll
        for (int i = 0; i < 16; ++i) wv[i] = __builtin_nontemporal_load((const f32x4*)(p.w_ada + (size_t)(wave * 128 + i * 8 + kk) * 3072 + n0 + 4 * c4));
#pragma unroll
        for (int i = 0; i < 16; ++i) cact[tid + 512 * i] = silu_f(cv[i]);
        __syncthreads();
        float acc[8][4];
#pragma unroll
        for (int b = 0; b < 8; ++b)
#pragma unroll
            for (int j = 0; j < 4; ++j) acc[b][j] = 0.f;
#pragma unroll
        for (int i = 0; i < 16; ++i) {
            const int k = wave * 128 + i * 8 + kk;
#pragma unroll
            for (int b = 0; b < 8; ++b) { const float ca = cact[b * 1024 + k];
                acc[b][0] += ca * wv[i].x; acc[b][1] += ca * wv[i].y; acc[b][2] += ca * wv[i].z; acc[b][3] += ca * wv[i].w; }
        }
#pragma unroll
        for (int b = 0; b < 8; ++b)
#pragma unroll
            for (int j = 0; j < 4; ++j) acc[b][j] += dpp_f<0x128, 0xf>(acc[b][j]);
        if ((lane & 15) < 8) {
#pragma unroll
            for (int b = 0; b < 8; ++b)
#pragma unroll
                for (int j = 0; j < 4; ++j) red[((wave * 4 + (lane >> 4)) * 8 + b) * 32 + 4 * (lane & 7) + j] = acc[b][j];
        }
        __syncthreads();
        if (tid < 256) { const int b = tid >> 5, col = tid & 31; float s = p.b_ada[n0 + col];
#pragma unroll
            for (int w = 0; w < 32; ++w) s += red[(w * 8 + b) * 32 + col];
            __hip_atomic_store(mod + b * 3072 + n0 + col, s, __ATOMIC_RELAXED, __HIP_MEMORY_SCOPE_AGENT); }
        asm volatile("s_waitcnt vmcnt(0)" ::: "memory");
        __syncthreads();
        if (tid == 0) __hip_atomic_fetch_add(modcnt, 1u, __ATOMIC_RELAXED, __HIP_MEMORY_SCOPE_AGENT);
    }
    __syncthreads();
    f32x4 xv[8][4];
    const bool has_rows = (int)blockIdx.x < MTOK / 64;
    if (has_rows) p1_load(p, xv, blockIdx.x, wave, lane);
    {
        LAS float* scr = (LAS float*)(lds + wave * 16384);
        constexpr int I_IN = (DM / 64) * (INW / 32), I_OUT = (DM / 64) * (DM / 32);
        const int nfree = (int)gridDim.x - N_GEMV_ITEMS;
        const bool spare = nfree >= 64;
        const int NGW = spare ? nfree * 8 : (int)gridDim.x * 8;
        const int gw = spare ? (((int)blockIdx.x >= N_GEMV_ITEMS) ? ((int)blockIdx.x - N_GEMV_ITEMS) * 8 + wave : (1 << 30)) : ((int)gridDim.x * 8 - 1 - ((int)blockIdx.x * 8 + wave));
        for (int it = gw; it < I_IN + I_OUT; it += NGW) {
            if (it < I_IN) p0_transpose_item(p.w_in, DM, INW, (bf16_t*)(p.ws + WS_WINT), scr, it, lane, true);
            else p0_transpose_item(p.w_out, DM, DM, (bf16_t*)(p.ws + WS_WOUTT), scr, it - I_IN, lane, false);
        }
    }
    for (int idx = blockIdx.x * 512 + tid; idx < SEQ * 32; idx += gridDim.x * 512) {
        const int pos = idx >> 5, i = idx & 31;
        const float inv = exp2f(-(float)i * 0.41524101186092033f);
        const float ang = (float)pos * inv;
        double t = (double)ang * 0.15915494309189535; t -= __builtin_floor(t);
        const float tf = (float)t;
        f32x2 cs; cs.x = __builtin_amdgcn_cosf(tf); cs.y = __builtin_amdgcn_sinf(tf);
        ((f32x2*)(p.ws + WS_ROPE))[idx] = cs;
    }
    if (tid == 0) {
        unsigned sp = 0;
        while (__hip_atomic_load(modcnt, __ATOMIC_RELAXED, __HIP_MEMORY_SCOPE_AGENT) < (unsigned)N_GEMV_ITEMS) { __builtin_amdgcn_s_sleep(2); if (++sp > (1u << 22)) break; }
        __builtin_amdgcn_fence(__ATOMIC_ACQUIRE, "agent");
        asm volatile("s_waitcnt vmcnt(0)" ::: "memory");
    }
    __syncthreads();
    if (has_rows) p1_finish(p, xv, blockIdx.x, wave, lane);
    for (int rb = blockIdx.x + gridDim.x; rb < MTOK / 64; rb += gridDim.x) { p1_load(p, xv, rb, wave, lane); p1_finish(p, xv, rb, wave, lane); }
}

constexpr int KS_STRIDE = 144, VT_STRIDE = 520, VT_OFF = 256 * KS_STRIDE, QS_OFF = VT_OFF + 64 * VT_STRIDE, QS_STRIDE = 144;
__device__ __forceinline__ void attn_unit(const Params& p, LAS unsigned char* lds, int unit, int tid, int wave, int lane) {
    const bf16_t* proj = (const bf16_t*)(p.ws + WS_PROJ);
    bf16_t* Y = (bf16_t*)(p.ws + WS_Y);
    const f32x2* rope = (const f32x2*)(p.ws + WS_ROPE);
    const int hk = unit & 1, n = (unit >> 1) & 15, b = unit >> 5;
    LAS unsigned char* Ks = lds;
    LAS unsigned char* Vt = lds + VT_OFF;
    LAS unsigned char* Qs = lds + QS_OFF;
    constexpr float LOG2E = 1.4426950408889634f;
    {
        const int key = tid >> 1, hf = tid & 1, posk = n * 128 - 128 + key, poskc = max(posk, 0);
        const bf16_t* kr = proj + (size_t)(b * SEQ + poskc) * INW + OFF_K + hk * 64 + 16 * hf;
        const u32x4 ka0 = *(const u32x4*)(kr), ka1 = *(const u32x4*)(kr + 8), kb0 = *(const u32x4*)(kr + 32), kb1 = *(const u32x4*)(kr + 40);
        const f32x4* kcs = (const f32x4*)(rope + poskc * 32 + 16 * hf);
        const LAS f32x4* kwp = (const LAS f32x4*)(lds + NW_OFF + 256 + 64 * hf);
        f32x4 kc[8], kwl[4], kwh[4];
#pragma unroll
        for (int i = 0; i < 8; ++i) kc[i] = kcs[i];
#pragma unroll
        for (int i = 0; i < 4; ++i) { kwl[i] = kwp[i]; kwh[i] = kwp[8 + i]; }
        const int kp = tid & 127, dg = tid >> 7, posv = n * 128 - 128 + 2 * kp, posvc = max(posv, 0);
        const bf16_t* vr = proj + (size_t)(b * SEQ + posvc) * INW + OFF_V + hk * 64 + 16 * dg;
        u32x4 va0 = *(const u32x4*)(vr), va1 = *(const u32x4*)(vr + 8), vb0 = *(const u32x4*)(vr + INW), vb1 = *(const u32x4*)(vr + INW + 8);
        const int qi = tid >> 2, hf2 = (tid >> 1) & 1, gp = tid & 1, posq = n * 128 + qi;
        const bf16_t* qr = proj + (size_t)(b * SEQ + posq) * INW + OFF_Q + (hk * 4 + 2 * gp) * 64 + 16 * hf2;
        u32x4 qa[2][4];
#pragma unroll
        for (int gg = 0; gg < 2; ++gg) { qa[gg][0] = *(const u32x4*)(qr + gg * 64); qa[gg][1] = *(const u32x4*)(qr + gg * 64 + 8); qa[gg][2] = *(const u32x4*)(qr + gg * 64 + 32); qa[gg][3] = *(const u32x4*)(qr + gg * 64 + 40); }
        {
            float lo[16], hi[16];
#pragma unroll
            for (int e = 0; e < 4; ++e) { lo[2 * e] = bflo(ka0[e]); lo[2 * e + 1] = bfhi(ka0[e]); lo[8 + 2 * e] = bflo(ka1[e]); lo[8 + 2 * e + 1] = bfhi(ka1[e]);
                                          hi[2 * e] = bflo(kb0[e]); hi[2 * e + 1] = bfhi(kb0[e]); hi[8 + 2 * e] = bflo(kb1[e]); hi[8 + 2 * e + 1] = bfhi(kb1[e]); }
            float ss = 0.f;
#pragma unroll
            for (int e = 0; e < 16; ++e) ss += lo[e] * lo[e] + hi[e] * hi[e];
            ss += __shfl_xor(ss, 1);
            const float rstd = posk >= 0 ? rsqrtf(ss * (1.0f / 64.0f) + EPS) : 0.f;
#pragma unroll
            for (int e = 0; e < 16; ++e) { const float cx = kc[e >> 1][2 * (e & 1)], cy = kc[e >> 1][2 * (e & 1) + 1];
                const float a = lo[e] * rstd * kwl[e >> 2][e & 3], bb = hi[e] * rstd * kwh[e >> 2][e & 3];
                lo[e] = a * cx - bb * cy; hi[e] = bb * cx + a * cy; }
            u32x4 o0, o1, o2, o3;
#pragma unroll
            for (int e = 0; e < 4; ++e) { o0[e] = pk(lo[2 * e], lo[2 * e + 1]); o1[e] = pk(lo[8 + 2 * e], lo[8 + 2 * e + 1]); o2[e] = pk(hi[2 * e], hi[2 * e + 1]); o3[e] = pk(hi[8 + 2 * e], hi[8 + 2 * e + 1]); }
            LAS unsigned char* kd = Ks + key * KS_STRIDE + 32 * hf;
            *(LAS u32x4*)(kd) = o0; *(LAS u32x4*)(kd + 16) = o1; *(LAS u32x4*)(kd + 64) = o2; *(LAS u32x4*)(kd + 80) = o3;
        }
        {
            if (posv < 0) { const u32x4 z = {0u, 0u, 0u, 0u}; va0 = z; va1 = z; vb0 = z; vb1 = z; }
            LAS unsigned char* vd = Vt + (16 * dg) * VT_STRIDE + 4 * kp;
#pragma unroll
            for (int e = 0; e < 4; ++e) {
                *(LAS unsigned*)(vd + (2 * e) * VT_STRIDE) = (va0[e] & 0xffffu) | (vb0[e] << 16);
                *(LAS unsigned*)(vd + (2 * e + 1) * VT_STRIDE) = (va0[e] >> 16) | (vb0[e] & 0xffff0000u);
                *(LAS unsigned*)(vd + (8 + 2 * e) * VT_STRIDE) = (va1[e] & 0xffffu) | (vb1[e] << 16);
                *(LAS unsigned*)(vd + (8 + 2 * e + 1) * VT_STRIDE) = (va1[e] >> 16) | (vb1[e] & 0xffff0000u);
            }
        }
        asm volatile("" ::: "memory");
        const f32x4* qcs = (const f32x4*)(rope + posq * 32 + 16 * hf2);
        const LAS f32x4* qwp = (const LAS f32x4*)(lds + NW_OFF + 64 * hf2);
        f32x4 qc[8], qwl[4], qwh[4];
#pragma unroll
        for (int i = 0; i < 8; ++i) qc[i] = qcs[i];
#pragma unroll
        for (int i = 0; i < 4; ++i) { qwl[i] = qwp[i]; qwh[i] = qwp[8 + i]; }
#pragma unroll
        for (int gg = 0; gg < 2; ++gg) {
            float lo[16], hi[16];
#pragma unroll
            for (int e = 0; e < 4; ++e) { lo[2 * e] = bflo(qa[gg][0][e]); lo[2 * e + 1] = bfhi(qa[gg][0][e]); lo[8 + 2 * e] = bflo(qa[gg][1][e]); lo[8 + 2 * e + 1] = bfhi(qa[gg][1][e]);
                                          hi[2 * e] = bflo(qa[gg][2][e]); hi[2 * e + 1] = bfhi(qa[gg][2][e]); hi[8 + 2 * e] = bflo(qa[gg][3][e]); hi[8 + 2 * e + 1] = bfhi(qa[gg][3][e]); }
            float ss = 0.f;
#pragma unroll
            for (int e = 0; e < 16; ++e) ss += lo[e] * lo[e] + hi[e] * hi[e];
            ss += __shfl_xor(ss, 2);
            const float rstd = rsqrtf(ss * (1.0f / 64.0f) + EPS) * (0.125f * LOG2E);
#pragma unroll
            for (int e = 0; e < 16; ++e) { const float cx = qc[e >> 1][2 * (e & 1)], cy = qc[e >> 1][2 * (e & 1) + 1];
                const float a = lo[e] * rstd * qwl[e >> 2][e & 3], bb = hi[e] * rstd * qwh[e >> 2][e & 3];
                lo[e] = a * cx - bb * cy; hi[e] = bb * cx + a * cy; }
            u32x4 o0, o1, o2, o3;
#pragma unroll
            for (int e = 0; e < 4; ++e) { o0[e] = pk(lo[2 * e], lo[2 * e + 1]); o1[e] = pk(lo[8 + 2 * e], lo[8 + 2 * e + 1]); o2[e] = pk(hi[2 * e], hi[2 * e + 1]); o3[e] = pk(hi[8 + 2 * e], hi[8 + 2 * e + 1]); }
            LAS unsigned char* qd = Qs + ((2 * gp + gg) * 128 + qi) * QS_STRIDE + 32 * hf2;
            *(LAS u32x4*)(qd) = o0; *(LAS u32x4*)(qd + 16) = o1; *(LAS u32x4*)(qd + 64) = o2; *(LAS u32x4*)(qd + 80) = o3;
        }
    }
    __syncthreads();
    const int g = wave >> 1, head = hk * 4 + g, qh = wave & 1, q = lane & 31, h = lane >> 5;
    const float sink2 = p.sinks[head] * LOG2E;
    bf16x8 Qf2[2][4];
#pragma unroll
    for (int sub = 0; sub < 2; ++sub) {
        const LAS unsigned char* qb = Qs + (g * 128 + 64 * qh + 32 * sub + q) * QS_STRIDE + 16 * h;
#pragma unroll
        for (int s4 = 0; s4 < 4; ++s4) Qf2[sub][s4] = *(const LAS bf16x8*)(qb + 32 * s4);
    }
    LAS unsigned char* ost = Qs + (g * 128 + 64 * qh) * QS_STRIDE;
    constexpr int OS_STRIDE = 272;
#pragma unroll
    for (int sub = 0; sub < 2; ++sub) {
        const int i0 = 64 * qh + 32 * sub, kt0 = 2 * qh + sub;
        const size_t row0 = (size_t)b * SEQ + n * 128 + i0;
        u32x4 graw[4];
#pragma unroll
        for (int i = 0; i < 4; ++i) graw[i] = __builtin_nontemporal_load((const u32x4*)(proj + (row0 + 8 * i + (lane >> 3)) * INW + OFF_GA + head * 64 + 8 * (lane & 7)));
        const bf16x8* Qf = Qf2[sub];
        f32x16 S[5];
#pragma unroll
        for (int t = 0; t < 5; ++t) {
#pragma unroll
            for (int r = 0; r < 16; ++r) S[t][r] = 0.f;
            const LAS unsigned char* kb = Ks + (32 * (kt0 + t) + q) * KS_STRIDE + 16 * h;
#pragma unroll
            for (int s = 0; s < 4; ++s) { const bf16x8 kf = *(const LAS bf16x8*)(kb + 32 * s);
                S[t] = __builtin_amdgcn_mfma_f32_32x32x16_bf16(kf, Qf[s], S[t], 0, 0, 0); }
        }
        float m = sink2;
#pragma unroll
        for (int t = 0; t < 5; ++t) {
            const bool tile_ok = (n > 0) || (kt0 + t >= 4);
#pragma unroll
            for (int r = 0; r < 16; ++r) {
                const int keyrow = (r & 3) + 8 * (r >> 2) + 4 * h;
                bool valid = tile_ok;
                if (t == 0) valid = valid && (keyrow > q);
                if (t == 4) valid = valid && (keyrow <= q);
                const float sv = valid ? S[t][r] : -1e30f;
                S[t][r] = sv; m = fmaxf(m, sv);
            }
        }
        m = fmaxf(m, __shfl_xor(m, 32));
        float l = 0.f;
#pragma unroll
        for (int t = 0; t < 5; ++t)
#pragma unroll
            for (int r = 0; r < 16; ++r) { const float pv = __builtin_amdgcn_exp2f(S[t][r] - m); S[t][r] = pv; l += pv; }
        l += __shfl_xor(l, 32);
        const float inv = __builtin_amdgcn_rcpf(l + __builtin_amdgcn_exp2f(sink2 - m));
        f32x16 O[2];
#pragma unroll
        for (int dt = 0; dt < 2; ++dt)
#pragma unroll
            for (int r = 0; r < 16; ++r) O[dt][r] = 0.f;
#pragma unroll
        for (int t = 0; t < 5; ++t)
#pragma unroll
            for (int s2 = 0; s2 < 2; ++s2) {
                u32x4 w; w.x = pk(S[t][8 * s2 + 0], S[t][8 * s2 + 1]); w.y = pk(S[t][8 * s2 + 2], S[t][8 * s2 + 3]); w.z = pk(S[t][8 * s2 + 4], S[t][8 * s2 + 5]); w.w = pk(S[t][8 * s2 + 6], S[t][8 * s2 + 7]);
                const bf16x8 pb = __builtin_bit_cast(bf16x8, w);
#pragma unroll
                for (int dt = 0; dt < 2; ++dt) {
                    const LAS unsigned char* vb = Vt + (32 * dt + q) * VT_STRIDE + 2 * (32 * (kt0 + t) + 16 * s2 + 4 * h);
                    const u32x2 v0 = *(const LAS u32x2*)(vb), v1 = *(const LAS u32x2*)(vb + 16);
                    u32x4 vv; vv.x = v0.x; vv.y = v0.y; vv.z = v1.x; vv.w = v1.y;
                    O[dt] = __builtin_amdgcn_mfma_f32_32x32x16_bf16(__builtin_bit_cast(bf16x8, vv), pb, O[dt], 0, 0, 0);
                }
            }
#pragma unroll
        for (int dt = 0; dt < 2; ++dt)
#pragma unroll
            for (int g4 = 0; g4 < 4; ++g4) { f32x4 ov = {O[dt][4 * g4 + 0] * inv, O[dt][4 * g4 + 1] * inv, O[dt][4 * g4 + 2] * inv, O[dt][4 * g4 + 3] * inv};
                *(LAS f32x4*)(ost + q * OS_STRIDE + (32 * dt + 8 * g4 + 4 * h) * 4) = ov; }
#pragma unroll
        for (int i = 0; i < 4; ++i) {
            const int r = 8 * i + (lane >> 3), c = lane & 7;
            const f32x4 a0 = *(const LAS f32x4*)(ost + r * OS_STRIDE + c * 32), a1 = *(const LAS f32x4*)(ost + r * OS_STRIDE + c * 32 + 16);
            const u32x4 gw = graw[i];
            u32x4 w; w.x = pk(a0.x * bflo(gw.x), a0.y * bfhi(gw.x)); w.y = pk(a0.z * bflo(gw.y), a0.w * bfhi(gw.y));
            w.z = pk(a1.x * bflo(gw.z), a1.y * bfhi(gw.z)); w.w = pk(a1.z * bflo(gw.w), a1.w * bfhi(gw.w));
            __builtin_nontemporal_store(w, (u32x4*)(Y + (row0 + r) * DM + head * 64 + 8 * c));
        }
        asm volatile("" ::: "memory");
    }
    __syncthreads();
}

constexpr int CO_OFF = 94 * 1024;
__device__ __forceinline__ void conv_unit(const Params& p, LAS unsigned char* lds, int unit, int tid, int wave, int lane) {
    const bf16_t* proj = (const bf16_t*)(p.ws + WS_PROJ);
    bf16_t* Y = (bf16_t*)(p.ws + WS_Y);
    const int b = unit >> 5, T0 = (unit & 31) * 64;
    const size_t rowbase = (size_t)b * SEQ;
    const int cp = tid & 255, sh = tid >> 8;
    {
        const bf16_t* Zb = (const bf16_t*)(p.ws + WS_Z);
        u32x4 zv[12];
#pragma unroll
        for (int i = 0; i < 12; ++i) {
            const int ch = tid + 512 * i, rel = min(ch >> 6, 93), c8 = ch & 63, pos = max(T0 - 30 + rel, 0);
            zv[i] = *(const u32x4*)(Zb + (rowbase + pos) * 512 + 8 * c8);
        }
#pragma unroll
        for (int i = 0; i < 12; ++i) {
            const int ch = tid + 512 * i, rel = ch >> 6, c8 = ch & 63;
            const u32x4 zero = {0u, 0u, 0u, 0u};
            if (rel < 94) *(LAS u32x4*)(lds + rel * 1024 + 16 * c8) = (T0 - 30 + rel) >= 0 ? zv[i] : zero;
        }
    }
    asm volatile("" ::: "memory");
    f32x2 wv[31];
#pragma unroll
    for (int j = 0; j < 31; ++j) wv[j] = *(const f32x2*)(p.conv_w + j * 512 + 2 * cp);
    const f32x2 bz = *(const f32x2*)(p.conv_b + 2 * cp);
    __syncthreads();
#pragma unroll 1
    for (int hh = 0; hh < 2; ++hh) {
        u32x4 gb[4];
#pragma unroll
        for (int r = 0; r < 4; ++r) gb[r] = *(const u32x4*)(proj + (rowbase + T0 + 32 * hh + wave * 4 + r) * INW + OFF_GB + 8 * lane);
        {
            f32x2 ac[16];
#pragma unroll
            for (int t = 0; t < 16; ++t) ac[t] = bz;
            const LAS unsigned char* zb = lds + (32 * hh + 16 * sh) * 1024 + 4 * cp;
#pragma unroll
            for (int r = 0; r < 46; ++r) {
                if ((r & 7) == 0) asm volatile("" ::: "memory");
                const unsigned zz = *(const LAS unsigned*)(zb + r * 1024);
                const f32x2 z2 = {bflo(zz), bfhi(zz)};
#pragma unroll
                for (int t = 0; t < 16; ++t) { const int j = r - t; if (j >= 0 && j <= 30) ac[t] = __builtin_elementwise_fma(wv[j], z2, ac[t]); }
            }
            if (hh) __syncthreads();
            LAS unsigned char* cb = lds + CO_OFF + (16 * sh) * 2048 + 8 * cp;
#pragma unroll
            for (int t = 0; t < 16; ++t) *(LAS f32x2*)(cb + t * 2048) = ac[t];
        }
        __syncthreads();
        const f32x4 lw0 = *(const f32x4*)(p.ln_w + 8 * lane), lw1 = *(const f32x4*)(p.ln_w + 8 * lane + 4);
        const f32x4 lb0 = *(const f32x4*)(p.ln_b + 8 * lane), lb1 = *(const f32x4*)(p.ln_b + 8 * lane + 4);
#pragma unroll
        for (int r = 0; r < 4; ++r) {
            const int tl = wave * 4 + r; const size_t row = rowbase + T0 + 32 * hh + tl;
            f32x4 v0 = *(const LAS f32x4*)(lds + CO_OFF + tl * 2048 + 32 * lane), v1 = *(const LAS f32x4*)(lds + CO_OFF + tl * 2048 + 32 * lane + 16);
            float s1 = (v0.x + v0.y) + (v0.z + v0.w) + (v1.x + v1.y) + (v1.z + v1.w);
            float s2 = (v0.x * v0.x + v0.y * v0.y) + (v0.z * v0.z + v0.w * v0.w) + (v1.x * v1.x + v1.y * v1.y) + (v1.z * v1.z + v1.w * v1.w);
            s1 = wave_sum(s1); s2 = wave_sum(s2);
            const float mean = s1 * (1.0f / 512.0f), var = fmaxf(s2 * (1.0f / 512.0f) - mean * mean, 0.f);
            const float rstd = rsqrtf(var + EPS);
            v0 = v0 - mean; v1 = v1 - mean;
            v0 = v0 * rstd * lw0 + lb0; v1 = v1 * rstd * lw1 + lb1;
            u32x4 o;
            o.x = pk(silu_f(v0.x) * bflo(gb[r].x), silu_f(v0.y) * bfhi(gb[r].x));
            o.y = pk(silu_f(v0.z) * bflo(gb[r].y), silu_f(v0.w) * bfhi(gb[r].y));
            o.z = pk(silu_f(v1.x) * bflo(gb[r].z), silu_f(v1.y) * bfhi(gb[r].z));
            o.w = pk(silu_f(v1.z) * bflo(gb[r].w), silu_f(v1.w) * bfhi(gb[r].w));
            __builtin_nontemporal_store(o, (u32x4*)(Y + row * DM + 512 + 8 * lane));
        }
    }
    __syncthreads();
}

__device__ __forceinline__ Params load_params() {
#if defined(__HIP_DEVICE_COMPILE__)
    const __attribute__((address_space(4))) Params* kp = (const __attribute__((address_space(4))) Params*)__builtin_amdgcn_kernarg_segment_ptr();
    asm volatile("" : "+s"(kp));
    return *kp;
#else
    return Params{};
#endif
}
__global__ void __launch_bounds__(512, 2) fwd_kernel(Params p) {
    extern __shared__ __attribute__((aligned(16))) unsigned char lds_raw[];
    LAS unsigned char* lds = (LAS unsigned char*)lds_raw;
    const int tid = threadIdx.x, lane = tid & 63, wave = __builtin_amdgcn_readfirstlane(tid >> 6);
    if (tid < 64) ((LAS unsigned*)(lds + MISC_OFF))[tid] = 0u;
    float nwv = 0.f;
    if (tid >= 128 && tid < 256) nwv = (tid < 192) ? p.q_norm_w[tid - 128] : p.k_norm_w[tid - 192];
    __syncthreads();
    XcdBarrier bar = xcd_barrier_post((unsigned*)(p.ws + WS_CTL), (volatile LAS unsigned*)(lds + MISC_OFF) + 8);
    if (p.never) cg::this_grid().sync();

    { const Params q = load_params(); phase01(q, lds, tid, wave, lane); }
    if (tid >= 128 && tid < 256) ((LAS float*)(lds + NW_OFF))[tid - 128] = nwv;
    xcd_barrier(bar);
    {
        const Params q = load_params();
        pg8::Gemm g{(const bf16_t*)(q.ws + WS_H), (const bf16_t*)(q.ws + WS_WINT), MTOK, INW, DM};
        pg8::StaticOrder S; S.init(MTOK, INW, (int)gridDim.x, (int)blockIdx.x);
        pg8::EpiProj E{(bf16_t*)(q.ws + WS_PROJ), INW, (bf16_t*)(q.ws + WS_Z)};
        pg8::gemm_phase<pg8::EpiProj, pg8::StaticOrder, GEMM_ALIGN, GEMM_SP2>(lds, g, S, E);
    }
    xcd_barrier(bar);
    for (int u = blockIdx.x; u < 256; u += gridDim.x) { const Params q = load_params(); attn_unit(q, lds, u, tid, wave, lane); }
    for (int u = blockIdx.x; u < 256; u += gridDim.x) { const Params q = load_params(); conv_unit(q, lds, u, tid, wave, lane); }
    xcd_barrier(bar);
    {
        const Params q = load_params();
        pg8::Gemm g{(const bf16_t*)(q.ws + WS_Y), (const bf16_t*)(q.ws + WS_WOUTT), MTOK, DM, DM};
        pg8::StaticOrder S; S.init(MTOK, DM, (int)gridDim.x, (int)blockIdx.x);
        pg8::EpiOut E{q.x, q.out, (const float*)(q.ws + WS_MOD)};
        pg8::gemm_phase<pg8::EpiOut, pg8::StaticOrder, false, GEMM_SP2>(lds, g, S, E);
    }
}

extern "C" void kernel_launch(void* const* d_in, const int* in_sizes, int n_in, void* d_out, int out_size, void* d_ws, size_t ws_size, hipStream_t stream) {
    static int grid = 0;
    if (grid == 0) {
        if (n_in != 14 || out_size != MTOK * DM || ws_size < WS_END) { fprintf(stderr, "kernel_launch: unexpected shapes (n_in %d, out %d, ws %zu)\n", n_in, out_size, ws_size); grid = -1; return; }
        int dev = 0, cus = 0, per_cu = 0;
        (void)hipGetDevice(&dev);
        (void)hipDeviceGetAttribute(&cus, hipDeviceAttributeMultiprocessorCount, dev);
        if (hipFuncSetAttribute((const void*)fwd_kernel, hipFuncAttributeMaxDynamicSharedMemorySize, LDS_BYTES) != hipSuccess) { fprintf(stderr, "kernel_launch: hipFuncSetAttribute failed\n"); grid = -1; return; }
        if (hipOccupancyMaxActiveBlocksPerMultiprocessor(&per_cu, (const void*)fwd_kernel, 512, LDS_BYTES) != hipSuccess || per_cu < 1) { fprintf(stderr, "kernel_launch: occupancy query says %d\n", per_cu); per_cu = 1; }
        (void)hipGetLastError();
        grid = cus > 0 ? cus : 256;
        if (grid > 256) grid = 256;
    }
    if (grid < 0) return;
    (void)hipMemsetAsync((char*)d_ws + WS_CTL, 0, CTL_BYTES, stream);
    Params p{};
    const float** pp = (const float**)&p;
    for (int i = 0; i < 14; ++i) pp[i] = (const float*)d_in[i];
    p.out = (float*)d_out; p.ws = (unsigned char*)d_ws; p.never = 0; p.pad = 0;
    void* args[] = {&p};
    const hipError_t e = hipLaunchCooperativeKernel((const void*)fwd_kernel, dim3(grid), dim3(512), args, LDS_BYTES, stream);
    if (e != hipSuccess) fprintf(stderr, "kernel_launch: cooperative launch failed: %s (grid %d)\n", hipGetErrorString(e), grid);
}
```

```cpp
#include <hip/hip_runtime.h>
#include <hip/hip_cooperative_groups.h>
#include <cstdio>
namespace cg = cooperative_groups;
#define GEMM_ALIGN true
#define GEMM_SP2 true
namespace pg8 {
#define PG8_LAS __attribute__((address_space(3)))
typedef unsigned short bf16_t;
typedef short bf16x8 __attribute__((ext_vector_type(8)));
typedef float f32x4 __attribute__((ext_vector_type(4)));
typedef unsigned u32x4 __attribute__((ext_vector_type(4)));
constexpr int BM = 256, BK = 64, HALF = 128, HTB = HALF * BK * 2  , STAGE_BYTES = 8 * HTB, NXCD = 8, WGM = 8;

__host__ __device__ __forceinline__ int lds_byte(int r, int c) { const int st = (r >> 4) * 2 + (c >> 5), rr = r & 15, cc = c & 31, ob = rr * 64 + cc * 2; return st * 1024 + (ob ^ (((ob >> 9) & 1) << 5)); }
__host__ __device__ __forceinline__ void stage_rc(int b, int& R, int& C) { const int st = b / 1024, sb = b % 1024, swz = sb ^ (((sb >> 9) & 1) << 5); R = (st >> 1) * 16 + swz / 64; C = (st & 1) * 32 + (swz % 64) / 2; }
__host__ __device__ __forceinline__ int perm32(int rho) { const int n = rho >> 4, i = rho & 15; return 8 * (i >> 2) + 4 * n + (i & 3); }

struct Unit { int pm, pn; };
struct Gemm { const bf16_t* A; const bf16_t* Bt; int M, N, K; };

struct StaticOrder {
    int nM, nN, nwg, G, c;
    __host__ __device__ void init(int M, int N, int G_, int c_) { nM = M / BM; nN = N / BM; nwg = nM * nN; G = G_; c = c_; }
    __host__ __device__ bool next(int i, Unit& u) const {
        const long L = (long)i * G + c; if (L >= nwg) return false;
        int wgid = (int)L; { const int q = nwg / NXCD, r = nwg % NXCD, xcd = wgid % NXCD, off = wgid / NXCD; wgid = (xcd < r ? xcd * (q + 1) : r * (q + 1) + (xcd - r) * q) + off; }
        const int nig = WGM * nN, gid = wgid / nig, fm = gid * WGM, gsz = (nM - fm) < WGM ? (nM - fm) : WGM;
        u.pm = fm + ((wgid % nig) % gsz); u.pn = (wgid % nig) / gsz; return true;
    }
    __device__ __forceinline__ void a_ready(const Unit&) const {}
    __device__ __forceinline__ void done(const Unit&) const {}
};
__device__ __forceinline__ unsigned cvt_pk_bf16(float lo, float hi) { unsigned r; asm volatile("v_cvt_pk_bf16_f32 %0, %1, %2" : "=v"(r) : "v"(lo), "v"(hi)); return r; }
template <class Epi, class Sched, bool ALIGN_EPI = false, bool SP2 = false>
__device__ __forceinline__ void gemm_phase(PG8_LAS unsigned char* lds, const Gemm g, const Sched& S, const Epi& E) {
    const int tid = threadIdx.x, wid = __builtin_amdgcn_readfirstlane(tid >> 6), lane = tid & 63, wr = wid >> 2, wc = wid & 3, fr = lane & 15, fq = lane >> 4;
    const int K = g.K, nt = K / BK;
    unsigned voffA[2], voffB[2];
#pragma unroll
    for (int i = 0; i < 2; ++i) { int R, C; stage_rc(tid * 16 + i * 8192, R, C); const int Rb = Epi::PERM ? ((R & ~31) + perm32(R & 31)) : R;
        voffA[i] = (unsigned)(R * K + C) * 2u; voffB[i] = (unsigned)(Rb * K + C) * 2u; }
    const size_t kstep = (size_t)(BK * 2);
    const size_t hstep = (size_t)HALF * K * 2;
    const size_t tstep = 2 * hstep;
    const unsigned ldsw = (unsigned)wid * 1024u;
    const int aoff = lds_byte(wr * 64 + fr, fq * 8), boff = lds_byte(wc * 32 + fr, fq * 8);
#define PG8_SA(b, h) (((b) * 2 + (h)) * HTB)
#define PG8_SB(b, h) ((4 + (b) * 2 + (h)) * HTB)
#define PG8_STAGE(bufoff, gbase, voff) do { _Pragma("unroll") for (int _i = 0; _i < 2; ++_i) \
        __builtin_amdgcn_global_load_lds((const unsigned*)((const char*)(gbase) + (voff)[_i]), (PG8_LAS unsigned*)(lds + (bufoff) + ldsw + _i * 8192), 16, 0, 0); } while (0)
#define PG8_LDA(dst, b, h) do { _Pragma("unroll") for (int m = 0; m < 4; ++m) _Pragma("unroll") for (int k = 0; k < 2; ++k) dst[m][k] = *(const PG8_LAS bf16x8*)(lds + PG8_SA(b, h) + aoff + m * 2048 + k * 1024); } while (0)
#define PG8_LDB(dst, b, h) do { _Pragma("unroll") for (int n = 0; n < 2; ++n) _Pragma("unroll") for (int k = 0; k < 2; ++k) dst[n][k] = *(const PG8_LAS bf16x8*)(lds + PG8_SB(b, h) + boff + n * 2048 + k * 1024); } while (0)
#define PG8_MMA(ai, bj, At, Bt) do { __builtin_amdgcn_s_setprio(1); _Pragma("unroll") for (int m = 0; m < 4; ++m) _Pragma("unroll") for (int n = 0; n < 2; ++n) _Pragma("unroll") for (int k = 0; k < 2; ++k) \
        acc[ai][bj][m][n] = __builtin_amdgcn_mfma_f32_16x16x32_bf16(Bt[n][k], At[m][k], acc[ai][bj][m][n], 0, 0, 0); __builtin_amdgcn_s_setprio(0); } while (0)
#define PG8_WAIT_V(n) asm volatile("s_waitcnt vmcnt(" #n ")" ::: "memory")
#define PG8_WAIT_L(n) asm volatile("s_waitcnt lgkmcnt(" #n ")" ::: "memory")
#define PG8_BAR __builtin_amdgcn_s_barrier()
#define PG8_SCHED __builtin_amdgcn_sched_barrier(0)
    Unit cur, nxt; int ui = 0;
    if (!S.next(0, cur)) return;
    f32x4 acc[2][2][4][2];
#pragma unroll
    for (int a = 0; a < 2; ++a)
#pragma unroll
        for (int b = 0; b < 2; ++b)
#pragma unroll
            for (int m = 0; m < 4; ++m)
#pragma unroll
                for (int n = 0; n < 2; ++n) acc[a][b][m][n] = (f32x4){0.f, 0.f, 0.f, 0.f};
    bf16x8 At[4][2], B0[2][2], B1[2][2];
    const char* cA = (const char*)g.A + (size_t)cur.pm * tstep; const char* cB = (const char*)g.Bt + (size_t)cur.pn * tstep;
    S.a_ready(cur);
    if constexpr (SP2) {
        PG8_STAGE(PG8_SB(0, 0), cB, voffB); PG8_STAGE(PG8_SB(0, 1), cB + hstep, voffB); PG8_STAGE(PG8_SA(0, 0), cA, voffA); PG8_STAGE(PG8_SA(0, 1), cA + hstep, voffA);
        if (wr == 1) PG8_BAR;
        PG8_WAIT_V(2); PG8_BAR;
        PG8_STAGE(PG8_SB(1, 0), cB + kstep, voffB); PG8_STAGE(PG8_SA(1, 0), cA + kstep, voffA); PG8_STAGE(PG8_SB(1, 1), cB + hstep + kstep, voffB);
        PG8_WAIT_V(6); PG8_BAR;
    } else {
        PG8_STAGE(PG8_SB(0, 0), cB, voffB); PG8_STAGE(PG8_SA(0, 0), cA, voffA); PG8_STAGE(PG8_SB(0, 1), cB + hstep, voffB); PG8_STAGE(PG8_SA(0, 1), cA + hstep, voffA);
        if (wr == 1) PG8_BAR;
        PG8_WAIT_V(4); PG8_BAR;
        PG8_STAGE(PG8_SB(1, 0), cB + kstep, voffB); PG8_STAGE(PG8_SA(1, 0), cA + kstep, voffA); PG8_STAGE(PG8_SB(1, 1), cB + hstep + kstep, voffB);
        PG8_WAIT_V(6); PG8_BAR;
    }
    for (;;) {
        const bool has_next = S.next(ui + 1, nxt);
        const char* nA = has_next ? (const char*)g.A + (size_t)nxt.pm * tstep : cA; const char* nB = has_next ? (const char*)g.Bt + (size_t)nxt.pn * tstep : cB;
        for (int t = 0; t < nt; t += 2) {
            const bool last = (t == nt - 2);
            const char* a1 = cA + (size_t)(t + 1) * kstep;
            const char* a2 = last ? nA : cA + (size_t)(t + 2) * kstep; const char* b2 = last ? nB : cB + (size_t)(t + 2) * kstep;
            const char* a3 = a2 + kstep; const char* b3 = b2 + kstep;
            if (last && has_next) S.a_ready(nxt);
            if constexpr (SP2) {
            PG8_LDB(B0, 0, 0); PG8_LDB(B1, 0, 1); PG8_SCHED; PG8_LDA(At, 0, 0); PG8_STAGE(PG8_SA(1, 1), a1 + hstep, voffA);
            PG8_WAIT_V(8); PG8_WAIT_L(0); PG8_BAR; PG8_MMA(0, 0, At, B0); PG8_MMA(0, 1, At, B1); PG8_BAR; PG8_SCHED;
            PG8_LDA(At, 0, 1); PG8_STAGE(PG8_SB(0, 0), b2, voffB); PG8_STAGE(PG8_SB(0, 1), b2 + hstep, voffB); PG8_STAGE(PG8_SA(0, 0), a2, voffA);
            PG8_WAIT_V(8); PG8_WAIT_L(0); PG8_BAR; PG8_MMA(1, 0, At, B0); PG8_MMA(1, 1, At, B1); PG8_BAR; PG8_SCHED;
            PG8_LDB(B0, 1, 0); PG8_LDB(B1, 1, 1); PG8_SCHED; PG8_LDA(At, 1, 0); PG8_STAGE(PG8_SA(0, 1), a2 + hstep, voffA);
            PG8_WAIT_V(8); PG8_WAIT_L(0); PG8_BAR; PG8_MMA(0, 0, At, B0); PG8_MMA(0, 1, At, B1); PG8_BAR; PG8_SCHED;
            PG8_LDA(At, 1, 1); PG8_STAGE(PG8_SB(1, 0), b3, voffB); PG8_STAGE(PG8_SB(1, 1), b3 + hstep, voffB); PG8_STAGE(PG8_SA(1, 0), a3, voffA);
            PG8_WAIT_V(8); PG8_WAIT_L(0); PG8_BAR; PG8_MMA(1, 0, At, B0); PG8_MMA(1, 1, At, B1); PG8_BAR; PG8_SCHED;
            } else {
            PG8_LDB(B0, 0, 0); PG8_SCHED; PG8_LDA(At, 0, 0); PG8_STAGE(PG8_SA(1, 1), a1 + hstep, voffA);
            PG8_WAIT_L(8); PG8_BAR; PG8_WAIT_L(0); PG8_MMA(0, 0, At, B0); PG8_BAR; PG8_SCHED;
            PG8_LDB(B1, 0, 1); PG8_STAGE(PG8_SB(0, 0), b2, voffB);
            PG8_BAR; PG8_WAIT_L(0); PG8_MMA(0, 1, At, B1); PG8_BAR;
            PG8_LDA(At, 0, 1); PG8_STAGE(PG8_SA(0, 0), a2, voffA);
            PG8_BAR; PG8_WAIT_L(0); PG8_MMA(1, 0, At, B0); PG8_BAR; PG8_SCHED;
            PG8_STAGE(PG8_SB(0, 1), b2 + hstep, voffB);
            PG8_WAIT_V(6); PG8_BAR; PG8_MMA(1, 1, At, B1); PG8_BAR;
            PG8_LDB(B0, 1, 0); PG8_SCHED; PG8_LDA(At, 1, 0); PG8_STAGE(PG8_SA(0, 1), a2 + hstep, voffA);
            PG8_WAIT_L(8); PG8_BAR; PG8_WAIT_L(0); PG8_MMA(0, 0, At, B0); PG8_BAR; PG8_SCHED;
            PG8_LDB(B1, 1, 1); PG8_STAGE(PG8_SB(1, 0), b3, voffB);
            PG8_BAR; PG8_WAIT_L(0); PG8_MMA(0, 1, At, B1); PG8_BAR;
            PG8_LDA(At, 1, 1); PG8_STAGE(PG8_SA(1, 0), a3, voffA);
            PG8_BAR; PG8_WAIT_L(0); PG8_MMA(1, 0, At, B0); PG8_BAR; PG8_SCHED;
            PG8_STAGE(PG8_SB(1, 1), b3 + hstep, voffB);
            PG8_WAIT_V(6); PG8_BAR; PG8_MMA(1, 1, At, B1); PG8_BAR;
            }
        }
        if constexpr (ALIGN_EPI) { if (wr == 0) PG8_BAR; }
        if constexpr (!Epi::AFTER_DRAIN) { E(acc, cur, wr, wc, fr, fq); S.done(cur); }
        if (!has_next) break;
#pragma unroll
        for (int a = 0; a < 2; ++a)
#pragma unroll
            for (int b = 0; b < 2; ++b)
#pragma unroll
                for (int m = 0; m < 4; ++m)
#pragma unroll
                    for (int n = 0; n < 2; ++n) acc[a][b][m][n] = (f32x4){0.f, 0.f, 0.f, 0.f};
        cur = nxt; cA = nA; cB = nB; ++ui;
        if constexpr (ALIGN_EPI) { if (wr == 1) PG8_BAR; }
    }
    PG8_WAIT_V(0);
    if constexpr (!ALIGN_EPI) { if (wr == 0) PG8_BAR; }
    PG8_BAR;
    if constexpr (Epi::AFTER_DRAIN) { E.fused(acc, cur, wr, wc, fr, fq, lds, wid, lane); S.done(cur); }
#undef PG8_SA
#undef PG8_SB
#undef PG8_STAGE
#undef PG8_LDA
#undef PG8_LDB
#undef PG8_MMA
#undef PG8_WAIT_V
#undef PG8_WAIT_L
#undef PG8_BAR
#undef PG8_SCHED
}
}
namespace pg8 {
struct EpiProj {
    static constexpr bool PERM = true, AFTER_DRAIN = false;
    bf16_t* O; int ldc; bf16_t* Z;
    __device__ __forceinline__ void operator()(const f32x4 (&acc)[2][2][4][2], const Unit& u, int wr, int wc, int fr, int fq) const {
        const int row0 = u.pm * BM + wr * 64 + fr;
        if (u.pn >= 5 && u.pn < 9) {
            const int zc = (u.pn - 5) * 128 + wc * 32 + 8 * fq;
#pragma unroll
            for (int ai = 0; ai < 2; ++ai)
#pragma unroll
                for (int m = 0; m < 4; ++m) { bf16_t* zp = Z + (size_t)(row0 + ai * HALF + m * 16) * 512 + zc;
                    const f32x4 a0 = acc[ai][0][m][0], a1 = acc[ai][0][m][1], g0 = acc[ai][1][m][0], g1 = acc[ai][1][m][1];
                    f32x4 z0, z1;
#pragma unroll
                    for (int e = 0; e < 4; ++e) { z0[e] = a0[e] * __builtin_amdgcn_rcpf(1.0f + __builtin_amdgcn_exp2f(g0[e] * -1.4426950408889634f));
                                                  z1[e] = a1[e] * __builtin_amdgcn_rcpf(1.0f + __builtin_amdgcn_exp2f(g1[e] * -1.4426950408889634f)); }
                    u32x4 w; w.x = cvt_pk_bf16(z0[0], z0[1]); w.y = cvt_pk_bf16(z0[2], z0[3]); w.z = cvt_pk_bf16(z1[0], z1[1]); w.w = cvt_pk_bf16(z1[2], z1[3]);
                    *(u32x4*)zp = w; }
            return;
        }
        const int col0 = u.pn * BM + wc * 32 + 8 * fq;
        const bool gate_tile = (u.pn == 3) || (u.pn == 4) || (u.pn >= 9);
#pragma unroll
        for (int ai = 0; ai < 2; ++ai)
#pragma unroll
            for (int m = 0; m < 4; ++m) { bf16_t* rowp = O + (size_t)(row0 + ai * HALF + m * 16) * ldc + col0;
#pragma unroll
                for (int bj = 0; bj < 2; ++bj) { f32x4 v0 = acc[ai][bj][m][0], v1 = acc[ai][bj][m][1];
                    if (gate_tile) {
#pragma unroll
                        for (int e = 0; e < 4; ++e) { v0[e] = v0[e] * __builtin_amdgcn_rcpf(1.0f + __builtin_amdgcn_exp2f(v0[e] * -1.4426950408889634f));
                                                      v1[e] = v1[e] * __builtin_amdgcn_rcpf(1.0f + __builtin_amdgcn_exp2f(v1[e] * -1.4426950408889634f)); } }
                    u32x4 w; w.x = cvt_pk_bf16(v0[0], v0[1]); w.y = cvt_pk_bf16(v0[2], v0[3]); w.z = cvt_pk_bf16(v1[0], v1[1]); w.w = cvt_pk_bf16(v1[2], v1[3]);
                    *(u32x4*)(rowp + bj * HALF) = w; } }
    }
};
struct EpiOut {
    static constexpr bool PERM = false, AFTER_DRAIN = false;
    const float* X; float* C; const float* mod;
    __device__ __forceinline__ void operator()(const f32x4 (&acc)[2][2][4][2], const Unit& u, int wr, int wc, int fr, int fq) const {
        const int row0 = u.pm * BM + wr * 64 + fr, col0 = u.pn * BM + wc * 32 + 4 * fq;
        const float* gp = mod + (size_t)(u.pm >> 3) * 3072 + 2048 + col0;
        const float* xb = X + (size_t)row0 * 1024 + col0; float* cb = C + (size_t)row0 * 1024 + col0;
        f32x4 gv[2][2];
#pragma unroll
        for (int bj = 0; bj < 2; ++bj)
#pragma unroll
            for (int n = 0; n < 2; ++n) gv[bj][n] = *(const f32x4*)(gp + bj * HALF + n * 16);
        constexpr int DEPTH = 4;
        f32x4 xs[DEPTH][2][2];
#pragma unroll
        for (int gi = 0; gi < DEPTH; ++gi) { const size_t off = (size_t)((gi >> 2) * HALF + (gi & 3) * 16) * 1024;
#pragma unroll
            for (int bj = 0; bj < 2; ++bj)
#pragma unroll
                for (int n = 0; n < 2; ++n) xs[gi][bj][n] = __builtin_nontemporal_load((const f32x4*)(xb + off + bj * HALF + n * 16)); }
#pragma unroll
        for (int gi = 0; gi < 8; ++gi) { const int ai = gi >> 2, m = gi & 3; const size_t off = (size_t)(ai * HALF + m * 16) * 1024;
#pragma unroll
            for (int bj = 0; bj < 2; ++bj)
#pragma unroll
                for (int n = 0; n < 2; ++n) __builtin_nontemporal_store(xs[gi % DEPTH][bj][n] + gv[bj][n] * acc[ai][bj][m][n], (f32x4*)(cb + off + bj * HALF + n * 16));
            if (gi + DEPTH < 8) { const int g2 = gi + DEPTH; const size_t off2 = (size_t)((g2 >> 2) * HALF + (g2 & 3) * 16) * 1024;
#pragma unroll
                for (int bj = 0; bj < 2; ++bj)
#pragma unroll
                    for (int n = 0; n < 2; ++n) xs[gi % DEPTH][bj][n] = __builtin_nontemporal_load((const f32x4*)(xb + off2 + bj * HALF + n * 16)); }
        }
    }
};
}
#define LAS __attribute__((address_space(3)))
typedef unsigned short bf16_t;
typedef float f32x2 __attribute__((ext_vector_type(2)));
typedef float f32x4 __attribute__((ext_vector_type(4)));
typedef float f32x16 __attribute__((ext_vector_type(16)));
typedef short bf16x8 __attribute__((ext_vector_type(8)));
typedef short s16x4 __attribute__((ext_vector_type(4)));
typedef unsigned u32x2 __attribute__((ext_vector_type(2)));
typedef unsigned u32x4 __attribute__((ext_vector_type(4)));
typedef __bf16 bf16x2_t __attribute__((ext_vector_type(2)));

constexpr int DM = 1024, NBATCH = 8, SEQ = 2048, MTOK = NBATCH * SEQ, INW = 2816;
constexpr int OFF_Q = 0, OFF_K = 512, OFF_V = 640, OFF_GA = 768, OFF_UA = 1280, OFF_UG = 1792, OFF_GB = 2304;
constexpr float EPS = 1e-6f;
constexpr size_t MiB = 1u << 20;
constexpr size_t WS_CTL = 0, CTL_BYTES = 64 * 1024;
constexpr size_t WS_MOD = 1 * MiB;
constexpr size_t WS_ROPE = 2 * MiB;
constexpr size_t WS_WINT = 4 * MiB;
constexpr size_t WS_WOUTT = 10 * MiB;
constexpr size_t WS_H = 16 * MiB;
constexpr size_t WS_PROJ = 48 * MiB;
constexpr size_t WS_Y = 144 * MiB;
constexpr size_t WS_Z = 176 * MiB;
constexpr size_t WS_END = 192 * MiB;
constexpr int RING_BYTES = 131072, LDS_BYTES = 163840, MISC_OFF = LDS_BYTES - 256, NW_OFF = 161792;

__device__ __forceinline__ float bflo(unsigned w) { return __uint_as_float(w << 16); }
__device__ __forceinline__ float bfhi(unsigned w) { return __uint_as_float(w & 0xffff0000u); }
__device__ __forceinline__ unsigned pk(float lo, float hi) { f32x2 v = {lo, hi}; bf16x2_t b = __builtin_convertvector(v, bf16x2_t); return __builtin_bit_cast(unsigned, b); }
template <int CTRL, int ROWMASK> __device__ __forceinline__ float dpp_f(float v) { return __builtin_bit_cast(float, __builtin_amdgcn_update_dpp(0, __builtin_bit_cast(int, v), CTRL, ROWMASK, 0xf, false)); }
__device__ __forceinline__ float wave_sum(float v) {
    v += dpp_f<0xB1, 0xf>(v);
    v += dpp_f<0x4E, 0xf>(v);
    v += dpp_f<0x141, 0xf>(v);
    v += dpp_f<0x140, 0xf>(v);
    v += dpp_f<0x142, 0xa>(v);
    v += dpp_f<0x143, 0xc>(v);
    return __builtin_bit_cast(float, __builtin_amdgcn_readlane(__builtin_bit_cast(int, v), 63));
}
__device__ __forceinline__ float sigm_f(float v) { return __builtin_amdgcn_rcpf(1.0f + __builtin_amdgcn_exp2f(v * -1.4426950408889634f)); }
__device__ __forceinline__ float silu_f(float v) { return v * sigm_f(v); }
#define LDS_WAIT() asm volatile("s_waitcnt lgkmcnt(0)" ::: "memory")

struct Params {
    const float *x, *c, *w_ada, *b_ada, *norm_w, *w_in, *q_norm_w, *k_norm_w, *sinks, *conv_w, *conv_b, *ln_w, *ln_b, *w_out;
    float* out; unsigned char* ws; int never; int pad;
};
#define XB_TMO      128
#define XB_XCNT(j)  (256  + 64 * (j))
#define XB_XSUB(j)  (1280 + 64 * (j))
#define XB_XGEN(j)  (2304 + 64 * (j))
#define XB_TOP      3328
#define XB_TOPGEN   3392
#define XCD_BAR_WORDS 3456
#define XB_SPIN_CAP (1u << 18)

__device__ __forceinline__ unsigned xb_ld(unsigned* p)              { return __hip_atomic_load(p, __ATOMIC_RELAXED, __HIP_MEMORY_SCOPE_AGENT); }
__device__ __forceinline__ unsigned xb_add(unsigned* p, unsigned v) { return __hip_atomic_fetch_add(p, v, __ATOMIC_RELAXED, __HIP_MEMORY_SCOPE_AGENT); }
__device__ __forceinline__ unsigned xb_xcc_id() { return (unsigned)__builtin_amdgcn_s_getreg((3 << 11) | 20) & 0xFu; }
#define XB_SPIN(cond, bar) do { unsigned _sp = 0; while (cond) { __builtin_amdgcn_s_sleep(1); \
    if ((++_sp & 255u) == 0u) { if (xb_ld(&(bar)[XB_TMO])) break; if (_sp > XB_SPIN_CAP) { atomicAdd(&(bar)[XB_TMO], 1u); break; } } } } while (0)

struct XcdBarrier {
    unsigned* bar; unsigned x;
    volatile LAS unsigned* st;
};

__device__ __forceinline__ XcdBarrier xcd_barrier_post(unsigned* bar, volatile LAS unsigned* st) {
    XcdBarrier b; b.bar = bar; b.x = xb_xcc_id(); b.st = st;
    if (threadIdx.x == 0) (void)xb_add(&bar[XB_XCNT(b.x)], 1u);
    return b;
}
__device__ __forceinline__ void xcd_barrier_complete(unsigned* bar, unsigned x, unsigned& nloc, unsigned& nx) {
    const unsigned G = gridDim.x * gridDim.y * gridDim.z;
    unsigned sum, cnt, mine, sp = 0u;
    for (;;) {
        sum = 0u; cnt = 0u; mine = 0u;
#pragma unroll
        for (unsigned j = 0; j < 16; ++j) { const unsigned c = xb_ld(&bar[XB_XCNT(j)]); sum += c; cnt += (c > 0u) ? 1u : 0u; mine = (j == x) ? c : mine; }
        if (sum == G) break;
        __builtin_amdgcn_s_sleep(1);
        if ((++sp & 255u) == 0u) { if (xb_ld(&bar[XB_TMO])) break; if (sp > XB_SPIN_CAP) { atomicAdd(&bar[XB_TMO], 1u); break; } }
    }
    nloc = mine > 0u ? mine : 1u; nx = cnt > 0u ? cnt : 1u;
}

__device__ __forceinline__ void xcd_barrier(const XcdBarrier& b) {
    asm volatile("s_waitcnt vmcnt(0)" ::: "memory");
    __syncthreads();
    if (threadIdx.x == 0) {
        unsigned* bar = b.bar;
        __builtin_amdgcn_s_waitcnt(0);
        unsigned nloc = b.st[0], nx = b.st[1];
        if (nloc == 0u) { xcd_barrier_complete(bar, b.x, nloc, nx); b.st[0] = nloc; b.st[1] = nx; }
        const unsigned old = xb_add(&bar[XB_XSUB(b.x)], 1u);
        const unsigned gen = old / nloc;
        if (old + 1u == (gen + 1u) * nloc) {
            __builtin_amdgcn_fence(__ATOMIC_RELEASE, "agent");
            asm volatile("s_waitcnt vmcnt(0)" ::: "memory");
            const unsigned og = xb_add(&bar[XB_TOP], 1u);
            const unsigned tg = og / nx;
            if (og + 1u == (tg + 1u) * nx) xb_add(&bar[XB_TOPGEN], 1u);
            else XB_SPIN(xb_ld(&bar[XB_TOPGEN]) == tg, bar);
            __builtin_amdgcn_fence(__ATOMIC_ACQUIRE, "agent");
            xb_add(&bar[XB_XGEN(b.x)], 1u);
            asm volatile("s_waitcnt vmcnt(0)" ::: "memory");
        } else {
            XB_SPIN(xb_ld(&bar[XB_XGEN(b.x)]) == gen, bar);
            __builtin_amdgcn_fence(__ATOMIC_ACQUIRE, "agent");
            asm volatile("s_waitcnt vmcnt(0)" ::: "memory");
        }
    }
    __syncthreads();
}
__device__ __forceinline__ int glu_col(int n0) {
    if (n0 >= OFF_UA && n0 < OFF_UG) { const int ch = n0 - OFF_UA; return OFF_UA + 256 * (ch >> 7) + (ch & 127); }
    if (n0 >= OFF_UG && n0 < OFF_GB) { const int ch = n0 - OFF_UG; return OFF_UA + 256 * (ch >> 7) + 128 + (ch & 127); }
    return n0;
}
__device__ __forceinline__ void p0_transpose_item(const float* W, int K, int N, bf16_t* WT, LAS float* scr, int item, int lane, bool remap) {
    const int nblk = N / 32, kb = item / nblk, nb = item % nblk, k0 = 64 * kb, n0 = 32 * nb, n0o = remap ? glu_col(n0) : n0;
    float tv[32];
#pragma unroll
    for (int i = 0; i < 32; ++i) tv[i] = __builtin_nontemporal_load(W + (size_t)(k0 + 2 * i + (lane >> 5)) * N + n0 + (lane & 31));
#pragma unroll
    for (int i = 0; i < 32; ++i) scr[(2 * i + (lane >> 5)) * 33 + (lane & 31)] = tv[i];
    LDS_WAIT(); asm volatile("" ::: "memory");
    const int c = lane & 7;
#pragma unroll
    for (int j = 0; j < 4; ++j) { const int n = (lane >> 3) + 8 * j; const LAS float* s = scr + (8 * c) * 33 + n;
        u32x4 o; o.x = pk(s[0 * 33], s[1 * 33]); o.y = pk(s[2 * 33], s[3 * 33]); o.z = pk(s[4 * 33], s[5 * 33]); o.w = pk(s[6 * 33], s[7 * 33]);
        *(u32x4*)(WT + (size_t)(n0o + n) * K + k0 + 8 * c) = o; }
    LDS_WAIT(); asm volatile("" ::: "memory");
}

constexpr int MODCNT_WORD = 8192;
constexpr int N_GEMV_ITEMS = 96;
__device__ __forceinline__ void p1_finish(const Params& p, const f32x4 (&v)[8][4], int rb, int wave, int lane) {
    const float* mod = (const float*)(p.ws + WS_MOD);
    bf16_t* H = (bf16_t*)(p.ws + WS_H);
    const int b = rb >> 5;
    f32x4 g[4], sh[4];
#pragma unroll
    for (int j = 0; j < 4; ++j) { const int k = 4 * lane + 256 * j;
        const f32x4 nw = *(const f32x4*)(p.norm_w + k), sc = *(const f32x4*)(mod + b * 3072 + 1024 + k);
        g[j] = nw * (sc + 1.0f); sh[j] = *(const f32x4*)(mod + b * 3072 + k); }
    const size_t row0 = (size_t)rb * 64 + wave * 8;
#pragma unroll
    for (int r = 0; r < 8; ++r) {
        float s = 0.f;
#pragma unroll
        for (int j = 0; j < 4; ++j) s += (v[r][j].x * v[r][j].x + v[r][j].y * v[r][j].y) + (v[r][j].z * v[r][j].z + v[r][j].w * v[r][j].w);
        const float rstd = rsqrtf(wave_sum(s) * (1.0f / DM) + EPS);
        u32x2* o8 = (u32x2*)(H + (row0 + r) * DM) + lane;
#pragma unroll
        for (int j = 0; j < 4; ++j) { const f32x4 hv = v[r][j] * rstd * g[j] + sh[j]; u32x2 w; w.x = pk(hv.x, hv.y); w.y = pk(hv.z, hv.w); __builtin_nontemporal_store(w, o8 + 64 * j); }
    }
}
__device__ __forceinline__ void p1_load(const Params& p, f32x4 (&v)[8][4], int rb, int wave, int lane) {
    const size_t row0 = (size_t)rb * 64 + wave * 8;
#pragma unroll
    for (int r = 0; r < 8; ++r) { const f32x4* xr = (const f32x4*)(p.x + (row0 + r) * DM) + lane;
#pragma unroll
        for (int j = 0; j < 4; ++j) v[r][j] = __builtin_nontemporal_load(xr + 64 * j); }
}
__device__ __forceinline__ void phase01(const Params& p, LAS unsigned char* lds, int tid, int wave, int lane) {
    float* mod = (float*)(p.ws + WS_MOD);
    unsigned* modcnt = (unsigned*)(p.ws + WS_CTL) + MODCNT_WORD;
    for (int item = blockIdx.x; item < N_GEMV_ITEMS; item += gridDim.x) {
        LAS float* cact = (LAS float*)lds;
        LAS float* red = (LAS float*)(lds + 32768);
        const int n0 = item * 32, kk = lane >> 3, c4 = lane & 7;
        float cv[16]; f32x4 wv[16];
#pragma unroll
        for (int i = 0; i < 16; ++i) cv[i] = p.c[tid + 512 * i];
#pragma unroll
        for (int i = 0; i < 16; ++i) wv[i] = __builtin_nontemporal_load((const f32x4*)(p.w_ada + (size_t)(wave * 128 + i * 8 + kk) * 3072 + n0 + 4 * c4));
#pragma unroll
        for (int i = 0; i < 16; ++i) cact[tid + 512 * i] = silu_f(cv[i]);
        __syncthreads();
        float acc[8][4];
#pragma unroll
        for (int b = 0; b < 8; ++b)
#pragma unroll
            for (int j = 0; j < 4; ++j) acc[b][j] = 0.f;
#pragma unroll
        for (int i = 0; i < 16; ++i) {
            const int k = wave * 128 + i * 8 + kk;
#pragma unroll
            for (int b = 0; b < 8; ++b) { const float ca = cact[b * 1024 + k];
                acc[b][0] += ca * wv[i].x; acc[b][1] += ca * wv[i].y; acc[b][2] += ca * wv[i].z; acc[b][3] += ca * wv[i].w; }
        }
#pragma unroll
        for (int b = 0; b < 8; ++b)
#pragma unroll
            for (int j = 0; j < 4; ++j) acc[b][j] += dpp_f<0x128, 0xf>(acc[b][j]);
        if ((lane & 15) < 8) {
#pragma unroll
            for (int b = 0; b < 8; ++b)
#pragma unroll
                for (int j = 0; j < 4; ++j) red[((wave * 4 + (lane >> 4)) * 8 + b) * 32 + 4 * (lane & 7) + j] = acc[b][j];
        }
        __syncthreads();
        if (tid < 256) { const int b = tid >> 5, col = tid & 31; float s = p.b_ada[n0 + col];
#pragma unroll
            for (int w = 0; w < 32; ++w) s += red[(w * 8 + b) * 32 + col];
            __hip_atomic_store(mod + b * 3072 + n0 + col, s, __ATOMIC_RELAXED, __HIP_MEMORY_SCOPE_AGENT); }
        asm volatile("s_waitcnt vmcnt(0)" ::: "memory");
        __syncthreads();
        if (tid == 0) __hip_atomic_fetch_add(modcnt, 1u, __ATOMIC_RELAXED, __HIP_MEMORY_SCOPE_AGENT);
    }
    __syncthreads();
    f32x4 xv[8][4];
    const bool has_rows = (int)blockIdx.x < MTOK / 64;
    if (has_rows) p1_load(p, xv, blockIdx.x, wave, lane);
    {
        LAS float* scr = (LAS float*)(lds + wave * 16384);
        constexpr int I_IN = (DM / 64) * (INW / 32), I_OUT = (DM / 64) * (DM / 32);
        const int nfree = (int)gridDim.x - N_GEMV_ITEMS;
        const bool spare = nfree >= 64;
        const int NGW = spare ? nfree * 8 : (int)gridDim.x * 8;
        const int gw = spare ? (((int)blockIdx.x >= N_GEMV_ITEMS) ? ((int)blockIdx.x - N_GEMV_ITEMS) * 8 + wave : (1 << 30)) : ((int)gridDim.x * 8 - 1 - ((int)blockIdx.x * 8 + wave));
        for (int it = gw; it < I_IN + I_OUT; it += NGW) {
            if (it < I_IN) p0_transpose_item(p.w_in, DM, INW, (bf16_t*)(p.ws + WS_WINT), scr, it, lane, true);
            else p0_transpose_item(p.w_out, DM, DM, (bf16_t*)(p.ws + WS_WOUTT), scr, it - I_IN, lane, false);
        }
    }
    for (int idx = blockIdx.x * 512 + tid; idx < SEQ * 32; idx += gridDim.x * 512) {
        const int pos = idx >> 5, i = idx & 31;
        const float inv = exp2f(-(float)i * 0.41524101186092033f);
        const float ang = (float)pos * inv;
        double t = (double)ang * 0.15915494309189535; t -= __builtin_floor(t);
        const float tf = (float)t;
        f32x2 cs; cs.x = __builtin_amdgcn_cosf(tf); cs.y = __builtin_amdgcn_sinf(tf);
        ((f32x2*)(p.ws + WS_ROPE))[idx] = cs;
    }
    if (tid == 0) {
        unsigned sp = 0;
        while (__hip_atomic_load(modcnt, __ATOMIC_RELAXED, __HIP_MEMORY_SCOPE_AGENT) < (unsigned)N_GEMV_ITEMS) { __builtin_amdgcn_s_sleep(2); if (++sp > (1u << 22)) break; }
        __builtin_amdgcn_fence(__ATOMIC_ACQUIRE, "agent");
        asm volatile("s_waitcnt vmcnt(0)" ::: "memory");
    }
    __syncthreads();
    if (has_rows) p1_finish(p, xv, blockIdx.x, wave, lane);
    for (int rb = blockIdx.x + gridDim.x; rb < MTOK / 64; rb += gridDim.x) { p1_load(p, xv, rb, wave, lane); p1_finish(p, xv, rb, wave, lane); }
}

constexpr int KS_STRIDE = 144, VT_STRIDE = 520, VT_OFF = 256 * KS_STRIDE, QS_OFF = VT_OFF + 64 * VT_STRIDE, QS_STRIDE = 144;
__device__ __forceinline__ void attn_unit(const Params& p, LAS unsigned char* lds, int unit, int tid, int wave, int lane) {
    const bf16_t* proj = (const bf16_t*)(p.ws + WS_PROJ);
    bf16_t* Y = (bf16_t*)(p.ws + WS_Y);
    const f32x2* rope = (const f32x2*)(p.ws + WS_ROPE);
    const int hk = unit & 1, n = (unit >> 1) & 15, b = unit >> 5;
    LAS unsigned char* Ks = lds;
    LAS unsigned char* Vt = lds + VT_OFF;
    LAS unsigned char* Qs = lds + QS_OFF;
    constexpr float LOG2E = 1.4426950408889634f;
    {
        const int key = tid >> 1, hf = tid & 1, posk = n * 128 - 128 + key, poskc = max(posk, 0);
        const bf16_t* kr = proj + (size_t)(b * SEQ + poskc) * INW + OFF_K + hk * 64 + 16 * hf;
        const u32x4 ka0 = *(const u32x4*)(kr), ka1 = *(const u32x4*)(kr + 8), kb0 = *(const u32x4*)(kr + 32), kb1 = *(const u32x4*)(kr + 40);
        const f32x4* kcs = (const f32x4*)(rope + poskc * 32 + 16 * hf);
        const LAS f32x4* kwp = (const LAS f32x4*)(lds + NW_OFF + 256 + 64 * hf);
        f32x4 kc[8], kwl[4], kwh[4];
#pragma unroll
        for (int i = 0; i < 8; ++i) kc[i] = kcs[i];
#pragma unroll
        for (int i = 0; i < 4; ++i) { kwl[i] = kwp[i]; kwh[i] = kwp[8 + i]; }
        const int kp = tid & 127, dg = tid >> 7, posv = n * 128 - 128 + 2 * kp, posvc = max(posv, 0);
        const bf16_t* vr = proj + (size_t)(b * SEQ + posvc) * INW + OFF_V + hk * 64 + 16 * dg;
        u32x4 va0 = *(const u32x4*)(vr), va1 = *(const u32x4*)(vr + 8), vb0 = *(const u32x4*)(vr + INW), vb1 = *(const u32x4*)(vr + INW + 8);
        const int qi = tid >> 2, hf2 = (tid >> 1) & 1, gp = tid & 1, posq = n * 128 + qi;
        const bf16_t* qr = proj + (size_t)(b * SEQ + posq) * INW + OFF_Q + (hk * 4 + 2 * gp) * 64 + 16 * hf2;
        u32x4 qa[2][4];
#pragma unroll
        for (int gg = 0; gg < 2; ++gg) { qa[gg][0] = *(const u32x4*)(qr + gg * 64); qa[gg][1] = *(const u32x4*)(qr + gg * 64 + 8); qa[gg][2] = *(const u32x4*)(qr + gg * 64 + 32); qa[gg][3] = *(const u32x4*)(qr + gg * 64 + 40); }
        {
            float lo[16], hi[16];
#pragma unroll
            for (int e = 0; e < 4; ++e) { lo[2 * e] = bflo(ka0[e]); lo[2 * e + 1] = bfhi(ka0[e]); lo[8 + 2 * e] = bflo(ka1[e]); lo[8 + 2 * e + 1] = bfhi(ka1[e]);
                                          hi[2 * e] = bflo(kb0[e]); hi[2 * e + 1] = bfhi(kb0[e]); hi[8 + 2 * e] = bflo(kb1[e]); hi[8 + 2 * e + 1] = bfhi(kb1[e]); }
            float ss = 0.f;
#pragma unroll
            for (int e = 0; e < 16; ++e) ss += lo[e] * lo[e] + hi[e] * hi[e];
            ss += __shfl_xor(ss, 1);
            const float rstd = posk >= 0 ? rsqrtf(ss * (1.0f / 64.0f) + EPS) : 0.f;
#pragma unroll
            for (int e = 0; e < 16; ++e) { const float cx = kc[e >> 1][2 * (e & 1)], cy = kc[e >> 1][2 * (e & 1) + 1];
                const float a = lo[e] * rstd * kwl[e >> 2][e & 3], bb = hi[e] * rstd * kwh[e >> 2][e & 3];
                lo[e] = a * cx - bb * cy; hi[e] = bb * cx + a * cy; }
            u32x4 o0, o1, o2, o3;
#pragma unroll
            for (int e = 0; e < 4; ++e) { o0[e] = pk(lo[2 * e], lo[2 * e + 1]); o1[e] = pk(lo[8 + 2 * e], lo[8 + 2 * e + 1]); o2[e] = pk(hi[2 * e], hi[2 * e + 1]); o3[e] = pk(hi[8 + 2 * e], hi[8 + 2 * e + 1]); }
            LAS unsigned char* kd = Ks + key * KS_STRIDE + 32 * hf;
            *(LAS u32x4*)(kd) = o0; *(LAS u32x4*)(kd + 16) = o1; *(LAS u32x4*)(kd + 64) = o2; *(LAS u32x4*)(kd + 80) = o3;
        }
        {
            if (posv < 0) { const u32x4 z = {0u, 0u, 0u, 0u}; va0 = z; va1 = z; vb0 = z; vb1 = z; }
            LAS unsigned char* vd = Vt + (16 * dg) * VT_STRIDE + 4 * kp;
#pragma unroll
            for (int e = 0; e < 4; ++e) {
                *(LAS unsigned*)(vd + (2 * e) * VT_STRIDE) = (va0[e] & 0xffffu) | (vb0[e] << 16);
                *(LAS unsigned*)(vd + (2 * e + 1) * VT_STRIDE) = (va0[e] >> 16) | (vb0[e] & 0xffff0000u);
                *(LAS unsigned*)(vd + (8 + 2 * e) * VT_STRIDE) = (va1[e] & 0xffffu) | (vb1[e] << 16);
                *(LAS unsigned*)(vd + (8 + 2 * e + 1) * VT_STRIDE) = (va1[e] >> 16) | (vb1[e] & 0xffff0000u);
            }
        }
        asm volatile("" ::: "memory");
        const f32x4* qcs = (const f32x4*)(rope + posq * 32 + 16 * hf2);
        const LAS f32x4* qwp = (const LAS f32x4*)(lds + NW_OFF + 64 * hf2);
        f32x4 qc[8], qwl[4], qwh[4];
#pragma unroll
        for (int i = 0; i < 8; ++i) qc[i] = qcs[i];
#pragma unroll
        for (int i = 0; i < 4; ++i) { qwl[i] = qwp[i]; qwh[i] = qwp[8 + i]; }
#pragma unroll
        for (int gg = 0; gg < 2; ++gg) {
            float lo[16], hi[16];
#pragma unroll
            for (int e = 0; e < 4; ++e) { lo[2 * e] = bflo(qa[gg][0][e]); lo[2 * e + 1] = bfhi(qa[gg][0][e]); lo[8 + 2 * e] = bflo(qa[gg][1][e]); lo[8 + 2 * e + 1] = bfhi(qa[gg][1][e]);
                                          hi[2 * e] = bflo(qa[gg][2][e]); hi[2 * e + 1] = bfhi(qa[gg][2][e]); hi[8 + 2 * e] = bflo(qa[gg][3][e]); hi[8 + 2 * e + 1] = bfhi(qa[gg][3][e]); }
            float ss = 0.f;
#pragma unroll
            for (int e = 0; e < 16; ++e) ss += lo[e] * lo[e] + hi[e] * hi[e];
            ss += __shfl_xor(ss, 2);
            const float rstd = rsqrtf(ss * (1.0f / 64.0f) + EPS) * (0.125f * LOG2E);
#pragma unroll
            for (int e = 0; e < 16; ++e) { const float cx = qc[e >> 1][2 * (e & 1)], cy = qc[e >> 1][2 * (e & 1) + 1];
                const float a = lo[e] * rstd * qwl[e >> 2][e & 3], bb = hi[e] * rstd * qwh[e >> 2][e & 3];
                lo[e] = a * cx - bb * cy; hi[e] = bb * cx + a * cy; }
            u32x4 o0, o1, o2, o3;
#pragma unroll
            for (int e = 0; e < 4; ++e) { o0[e] = pk(lo[2 * e], lo[2 * e + 1]); o1[e] = pk(lo[8 + 2 * e], lo[8 + 2 * e + 1]); o2[e] = pk(hi[2 * e], hi[2 * e + 1]); o3[e] = pk(hi[8 + 2 * e], hi[8 + 2 * e + 1]); }
            LAS unsigned char* qd = Qs + ((2 * gp + gg) * 128 + qi) * QS_STRIDE + 32 * hf2;
            *(LAS u32x4*)(qd) = o0; *(LAS u32x4*)(qd + 16) = o1; *(LAS u32x4*)(qd + 64) = o2; *(LAS u32x4*)(qd + 80) = o3;
        }
    }
    __syncthreads();
    const int g = wave >> 1, head = hk * 4 + g, qh = wave & 1, q = lane & 31, h = lane >> 5;
    const float sink2 = p.sinks[head] * LOG2E;
    bf16x8 Qf2[2][4];
#pragma unroll
    for (int sub = 0; sub < 2; ++sub) {
        const LAS unsigned char* qb = Qs + (g * 128 + 64 * qh + 32 * sub + q) * QS_STRIDE + 16 * h;
#pragma unroll
        for (int s4 = 0; s4 < 4; ++s4) Qf2[sub][s4] = *(const LAS bf16x8*)(qb + 32 * s4);
    }
    LAS unsigned char* ost = Qs + (g * 128 + 64 * qh) * QS_STRIDE;
    constexpr int OS_STRIDE = 272;
#pragma unroll
    for (int sub = 0; sub < 2; ++sub) {
        const int i0 = 64 * qh + 32 * sub, kt0 = 2 * qh + sub;
        const size_t row0 = (size_t)b * SEQ + n * 128 + i0;
        u32x4 graw[4];
#pragma unroll
        for (int i = 0; i < 4; ++i) graw[i] = __builtin_nontemporal_load((const u32x4*)(proj + (row0 + 8 * i + (lane >> 3)) * INW + OFF_GA + head * 64 + 8 * (lane & 7)));
        const bf16x8* Qf = Qf2[sub];
        f32x16 S[5];
#pragma unroll
        for (int t = 0; t < 5; ++t) {
#pragma unroll
            for (int r = 0; r < 16; ++r) S[t][r] = 0.f;
            const LAS unsigned char* kb = Ks + (32 * (kt0 + t) + q) * KS_STRIDE + 16 * h;
#pragma unroll
            for (int s = 0; s < 4; ++s) { const bf16x8 kf = *(const LAS bf16x8*)(kb + 32 * s);
                S[t] = __builtin_amdgcn_mfma_f32_32x32x16_bf16(kf, Qf[s], S[t], 0, 0, 0); }
        }
        float m = sink2;
#pragma unroll
        for (int t = 0; t < 5; ++t) {
            const bool tile_ok = (n > 0) || (kt0 + t >= 4);
#pragma unroll
            for (int r = 0; r < 16; ++r) {
                const int keyrow = (r & 3) + 8 * (r >> 2) + 4 * h;
                bool valid = tile_ok;
                if (t == 0) valid = valid && (keyrow > q);
                if (t == 4) valid = valid && (keyrow <= q);
                const float sv = valid ? S[t][r] : -1e30f;
                S[t][r] = sv; m = fmaxf(m, sv);
            }
        }
        m = fmaxf(m, __shfl_xor(m, 32));
        float l = 0.f;
#pragma unroll
        for (int t = 0; t < 5; ++t)
#pragma unroll
            for (int r = 0; r < 16; ++r) { const float pv = __builtin_amdgcn_exp2f(S[t][r] - m); S[t][r] = pv; l += pv; }
        l += __shfl_xor(l, 32);
        const float inv = __builtin_amdgcn_rcpf(l + __builtin_amdgcn_exp2f(sink2 - m));
        f32x16 O[2];
#pragma unroll
        for (int dt = 0; dt < 2; ++dt)
#pragma unroll
            for (int r = 0; r < 16; ++r) O[dt][r] = 0.f;
#pragma unroll
        for (int t = 0; t < 5; ++t)
#pragma unroll
            for (int s2 = 0; s2 < 2; ++s2) {
                u32x4 w; w.x = pk(S[t][8 * s2 + 0], S[t][8 * s2 + 1]); w.y = pk(S[t][8 * s2 + 2], S[t][8 * s2 + 3]); w.z = pk(S[t][8 * s2 + 4], S[t][8 * s2 + 5]); w.w = pk(S[t][8 * s2 + 6], S[t][8 * s2 + 7]);
                const bf16x8 pb = __builtin_bit_cast(bf16x8, w);
#pragma unroll
                for (int dt = 0; dt < 2; ++dt) {
                    const LAS unsigned char* vb = Vt + (32 * dt + q) * VT_STRIDE + 2 * (32 * (kt0 + t) + 16 * s2 + 4 * h);
                    const u32x2 v0 = *(const LAS u32x2*)(vb), v1 = *(const LAS u32x2*)(vb + 16);
                    u32x4 vv; vv.x = v0.x; vv.y = v0.y; vv.z = v1.x; vv.w = v1.y;
                    O[dt] = __builtin_amdgcn_mfma_f32_32x32x16_bf16(__builtin_bit_cast(bf16x8, vv), pb, O[dt], 0, 0, 0);
                }
            }
#pragma unroll
        for (int dt = 0; dt < 2; ++dt)
#pragma unroll
            for (int g4 = 0; g4 < 4; ++g4) { f32x4 ov = {O[dt][4 * g4 + 0] * inv, O[dt][4 * g4 + 1] * inv, O[dt][4 * g4 + 2] * inv, O[dt][4 * g4 + 3] * inv};
                *(LAS f32x4*)(ost + q * OS_STRIDE + (32 * dt + 8 * g4 + 4 * h) * 4) = ov; }
#pragma unroll
        for (int i = 0; i < 4; ++i) {
            const int r = 8 * i + (lane >> 3), c = lane & 7;
            const f32x4 a0 = *(const LAS f32x4*)(ost + r * OS_STRIDE + c * 32), a1 = *(const LAS f32x4*)(ost + r * OS_STRIDE + c * 32 + 16);
            const u32x4 gw = graw[i];
            u32x4 w; w.x = pk(a0.x * bflo(gw.x), a0.y * bfhi(gw.x)); w.y = pk(a0.z * bflo(gw.y), a0.w * bfhi(gw.y));
            w.z = pk(a1.x * bflo(gw.z), a1.y * bfhi(gw.z)); w.w = pk(a1.z * bflo(gw.w), a1.w * bfhi(gw.w));
            __builtin_nontemporal_store(w, (u32x4*)(Y + (row0 + r) * DM + head * 64 + 8 * c));
        }
        asm volatile("" ::: "memory");
    }
    __syncthreads();
}

constexpr int CO_OFF = 94 * 1024;
__device__ __forceinline__ void conv_unit(const Params& p, LAS unsigned char* lds, int unit, int tid, int wave, int lane) {
    const bf16_t* proj = (const bf16_t*)(p.ws + WS_PROJ);
    bf16_t* Y = (bf16_t*)(p.ws + WS_Y);
    const int b = unit >> 5, T0 = (unit & 31) * 64;
    const size_t rowbase = (size_t)b * SEQ;
    const int cp = tid & 255, sh = tid >> 8;
    {
        const bf16_t* Zb = (const bf16_t*)(p.ws + WS_Z);
        u32x4 zv[12];
#pragma unroll
        for (int i = 0; i < 12; ++i) {
            const int ch = tid + 512 * i, rel = min(ch >> 6, 93), c8 = ch & 63, pos = max(T0 - 30 + rel, 0);
            zv[i] = *(const u32x4*)(Zb + (rowbase + pos) * 512 + 8 * c8);
        }
#pragma unroll
        for (int i = 0; i < 12; ++i) {
            const int ch = tid + 512 * i, rel = ch >> 6, c8 = ch & 63;
            const u32x4 zero = {0u, 0u, 0u, 0u};
            if (rel < 94) *(LAS u32x4*)(lds + rel * 1024 + 16 * c8) = (T0 - 30 + rel) >= 0 ? zv[i] : zero;
        }
    }
    asm volatile("" ::: "memory");
    f32x2 wv[31];
#pragma unroll
    for (int j = 0; j < 31; ++j) wv[j] = *(const f32x2*)(p.conv_w + j * 512 + 2 * cp);
    const f32x2 bz = *(const f32x2*)(p.conv_b + 2 * cp);
    __syncthreads();
#pragma unroll 1
    for (int hh = 0; hh < 2; ++hh) {
        u32x4 gb[4];
#pragma unroll
        for (int r = 0; r < 4; ++r) gb[r] = *(const u32x4*)(proj + (rowbase + T0 + 32 * hh + wave * 4 + r) * INW + OFF_GB + 8 * lane);
        {
            f32x2 ac[16];
#pragma unroll
            for (int t = 0; t < 16; ++t) ac[t] = bz;
            const LAS unsigned char* zb = lds + (32 * hh + 16 * sh) * 1024 + 4 * cp;
#pragma unroll
            for (int r = 0; r < 46; ++r) {
                if ((r & 7) == 0) asm volatile("" ::: "memory");
                const unsigned zz = *(const LAS unsigned*)(zb + r * 1024);
                const f32x2 z2 = {bflo(zz), bfhi(zz)};
#pragma unroll
                for (int t = 0; t < 16; ++t) { const int j = r - t; if (j >= 0 && j <= 30) ac[t] = __builtin_elementwise_fma(wv[j], z2, ac[t]); }
            }
            if (hh) __syncthreads();
            LAS unsigned char* cb = lds + CO_OFF + (16 * sh) * 2048 + 8 * cp;
#pragma unroll
            for (int t = 0; t < 16; ++t) *(LAS f32x2*)(cb + t * 2048) = ac[t];
        }
        __syncthreads();
        const f32x4 lw0 = *(const f32x4*)(p.ln_w + 8 * lane), lw1 = *(const f32x4*)(p.ln_w + 8 * lane + 4);
        const f32x4 lb0 = *(const f32x4*)(p.ln_b + 8 * lane), lb1 = *(const f32x4*)(p.ln_b + 8 * lane + 4);
#pragma unroll
        for (int r = 0; r < 4; ++r) {
            const int tl = wave * 4 + r; const size_t row = rowbase + T0 + 32 * hh + tl;
            f32x4 v0 = *(const LAS f32x4*)(lds + CO_OFF + tl * 2048 + 32 * lane), v1 = *(const LAS f32x4*)(lds + CO_OFF + tl * 2048 + 32 * lane + 16);
            float s1 = (v0.x + v0.y) + (v0.z + v0.w) + (v1.x + v1.y) + (v1.z + v1.w);
            float s2 = (v0.x * v0.x + v0.y * v0.y) + (v0.z * v0.z + v0.w * v0.w) + (v1.x * v1.x + v1.y * v1.y) + (v1.z * v1.z + v1.w * v1.w);
            s1 = wave_sum(s1); s2 = wave_sum(s2);
            const float mean = s1 * (1.0f / 512.0f), var = fmaxf(s2 * (1.0f / 512.0f) - mean * mean, 0.f);
            const float rstd = rsqrtf(var + EPS);
            v0 = v0 - mean; v1 = v1 - mean;
            v0 = v0 * rstd * lw0 + lb0; v1 = v1 * rstd * lw1 + lb1;
            u32x4 o;
            o.x = pk(silu_f(v0.x) * bflo(gb[r].x), silu_f(v0.y) * bfhi(gb[r].x));
            o.y = pk(silu_f(v0.z) * bflo(gb[r].y), silu_f(v0.w) * bfhi(gb[r].y));
            o.z = pk(silu_f(v1.x) * bflo(gb[r].z), silu_f(v1.y) * bfhi(gb[r].z));
            o.w = pk(silu_f(v1.z) * bflo(gb[r].w), silu_f(v1.w) * bfhi(gb[r].w));
            __builtin_nontemporal_store(o, (u32x4*)(Y + row * DM + 512 + 8 * lane));
        }
    }
    __syncthreads();
}

__device__ __forceinline__ Params load_params() {
#if defined(__HIP_DEVICE_COMPILE__)
    const __attribute__((address_space(4))) Params* kp = (const __attribute__((address_space(4))) Params*)__builtin_amdgcn_kernarg_segment_ptr();
    asm volatile("" : "+s"(kp));
    return *kp;
#else
    return Params{};
#endif
}
__global__ void __launch_bounds__(512, 2) fwd_kernel(Params p) {
    extern __shared__ __attribute__((aligned(16))) unsigned char lds_raw[];
    LAS unsigned char* lds = (LAS unsigned char*)lds_raw;
    const int tid = threadIdx.x, lane = tid & 63, wave = __builtin_amdgcn_readfirstlane(tid >> 6);
    if (tid < 64) ((LAS unsigned*)(lds + MISC_OFF))[tid] = 0u;
    float nwv = 0.f;
    if (tid >= 128 && tid < 256) nwv = (tid < 192) ? p.q_norm_w[tid - 128] : p.k_norm_w[tid - 192];
    __syncthreads();
    XcdBarrier bar = xcd_barrier_post((unsigned*)(p.ws + WS_CTL), (volatile LAS unsigned*)(lds + MISC_OFF) + 8);
    if (p.never) cg::this_grid().sync();

    { const Params q = load_params(); phase01(q, lds, tid, wave, lane); }
    if (tid >= 128 && tid < 256) ((LAS float*)(lds + NW_OFF))[tid - 128] = nwv;
    xcd_barrier(bar);
    {
        const Params q = load_params();
        pg8::Gemm g{(const bf16_t*)(q.ws + WS_H), (const bf16_t*)(q.ws + WS_WINT), MTOK, INW, DM};
        pg8::StaticOrder S; S.init(MTOK, INW, (int)gridDim.x, (int)blockIdx.x);
        pg8::EpiProj E{(bf16_t*)(q.ws + WS_PROJ), INW, (bf16_t*)(q.ws + WS_Z)};
        pg8::gemm_phase<pg8::EpiProj, pg8::StaticOrder, GEMM_ALIGN, GEMM_SP2>(lds, g, S, E);
    }
    xcd_barrier(bar);
    for (int v = blockIdx.x; v < 256; v += gridDim.x) { const int u = (gridDim.x == 256) ? ((v & 7) * 32 + (v >> 3)) : v; const Params q = load_params(); attn_unit(q, lds, u, tid, wave, lane); }
    for (int v = blockIdx.x; v < 256; v += gridDim.x) { const int u = (gridDim.x == 256) ? ((v & 7) * 32 + (v >> 3)) : v; const Params q = load_params(); conv_unit(q, lds, u, tid, wave, lane); }
    xcd_barrier(bar);
    {
        const Params q = load_params();
        pg8::Gemm g{(const bf16_t*)(q.ws + WS_Y), (const bf16_t*)(q.ws + WS_WOUTT), MTOK, DM, DM};
        pg8::StaticOrder S; S.init(MTOK, DM, (int)gridDim.x, (int)blockIdx.x);
        pg8::EpiOut E{q.x, q.out, (const float*)(q.ws + WS_MOD)};
        pg8::gemm_phase<pg8::EpiOut, pg8::StaticOrder, false, GEMM_SP2>(lds, g, S, E);
    }
}

extern "C" void kernel_launch(void* const* d_in, const int* in_sizes, int n_in, void* d_out, int out_size, void* d_ws, size_t ws_size, hipStream_t stream) {
    static int grid = 0;
    if (grid == 0) {
        if (n_in != 14 || out_size != MTOK * DM || ws_size < WS_END) { fprintf(stderr, "kernel_launch: unexpected shapes (n_in %d, out %d, ws %zu)\n", n_in, out_size, ws_size); grid = -1; return; }
        int dev = 0, cus = 0, per_cu = 0;
        (void)hipGetDevice(&dev);
        (void)hipDeviceGetAttribute(&cus, hipDeviceAttributeMultiprocessorCount, dev);
        if (hipFuncSetAttribute((const void*)fwd_kernel, hipFuncAttributeMaxDynamicSharedMemorySize, LDS_BYTES) != hipSuccess) { fprintf(stderr, "kernel_launch: hipFuncSetAttribute failed\n"); grid = -1; return; }
        if (hipOccupancyMaxActiveBlocksPerMultiprocessor(&per_cu, (const void*)fwd_kernel, 512, LDS_BYTES) != hipSuccess || per_cu < 1) { fprintf(stderr, "kernel_launch: occupancy query says %d\n", per_cu); per_cu = 1; }
        (void)hipGetLastError();
        grid = cus > 0 ? cus : 256;
        if (grid > 256) grid = 256;
    }
    if (grid < 0) return;
    (void)hipMemsetAsync((char*)d_ws + WS_CTL, 0, CTL_BYTES, stream);
    Params p{};
    const float** pp = (const float**)&p;
    for (int i = 0; i < 14; ++i) pp[i] = (const float*)d_in[i];
    p.out = (float*)d_out; p.ws = (unsigned char*)d_ws; p.never = 0; p.pad = 0;
    void* args[] = {&p};
    const hipError_t e = hipLaunchCooperativeKernel((const void*)fwd_kernel, dim3(grid), dim3(512), args, LDS_BYTES, stream);
    if (e != hipSuccess) fprintf(stderr, "kernel_launch: cooperative launch failed: %s (grid %d)\n", hipGetErrorString(e), grid);
}
```
